# Optimizing an MI355X kernel written in HIP

```python
import math
import jax, jax.numpy as jnp
from jax import lax
import numpy as np

D_MODEL = 1024
BATCH = 8
SEQ = 2048
DEPTH = 4
DEC_BATCH = 128
DEC_SEQ = 1
PAST_LEN = 16384
PAGE_SIZE = 128

N_MIXERS = 2
N_SSM_LAYERS = (DEPTH + 1) // 2
N_CONV_LAYERS = DEPTH // 2
GROUP_SIZE = 16
N_GROUPS = D_MODEL // GROUP_SIZE
STATE_DIM = 64
CONV_WIDTH = 3
D_FF = 4 * D_MODEL
RMS_EPS = 1e-6
DT_MIN = 1e-3
DT_MAX = 1e-1

kernel_name = "s5_shortconv_hybrid_decode_step"


def rms_norm(x, g):
    xf = x.astype(jnp.float32)
    ms = jnp.mean(xf * xf, axis=-1, keepdims=True)
    return (xf * lax.rsqrt(ms + RMS_EPS) * g.astype(jnp.float32)).astype(x.dtype)


def _ssm_combine(left, right):
    a_l, b_l = left
    a_r, b_r = right
    return a_r * a_l, a_r * b_l + b_r


def s5_mixer(u, h0_re, h0_im, a_re, a_im, log_dt, b_re, b_im, c_re, c_im, d_skip, w_glu):
    bt, s, _ = u.shape
    uf = u.astype(jnp.float32).reshape(bt, s, N_GROUPS, GROUP_SIZE)
    a = lax.complex(a_re.astype(jnp.float32), a_im.astype(jnp.float32))
    dt = jnp.exp(log_dt.astype(jnp.float32))[:, None]
    a_bar = jnp.exp(a * dt)
    b_c = lax.complex(b_re.astype(jnp.float32), b_im.astype(jnp.float32))
    c_c = lax.complex(c_re.astype(jnp.float32), c_im.astype(jnp.float32))
    b_bar = ((a_bar - 1.0) / a)[..., None] * b_c
    bu = jnp.einsum('gph,bsgh->bsgp', b_bar, uf.astype(jnp.complex64))
    h0 = lax.complex(h0_re.astype(jnp.float32), h0_im.astype(jnp.float32))
    bu = bu.at[:, 0].add(a_bar[None] * h0)
    a_seq = jnp.broadcast_to(a_bar, bu.shape)
    _, h = lax.associative_scan(_ssm_combine, (a_seq, bu), axis=1)
    y = jnp.einsum('ghp,bsgp->bsgh', c_c, h).real + d_skip.astype(jnp.float32).reshape(N_GROUPS, GROUP_SIZE) * uf
    y = jax.nn.gelu(y.reshape(bt, s, D_MODEL))
    z = y @ w_glu.astype(jnp.float32)
    out = z[..., :D_MODEL] * jax.nn.sigmoid(z[..., D_MODEL:])
    h_last = h[:, -1]
    return out.astype(u.dtype), h_last.real, h_last.imag


def short_conv_mixer(u, buf, w_in, conv_w, w_out):
    s = u.shape[1]
    bcv = u @ w_in
    gate_b = bcv[..., :D_MODEL]
    gate_c = bcv[..., D_MODEL:2 * D_MODEL]
    v = bcv[..., 2 * D_MODEL:]
    cv = gate_c * v
    xp = jnp.concatenate([buf.astype(cv.dtype), cv], axis=1)
    y = conv_w[0] * xp[:, 0:s]
    for k in range(1, CONV_WIDTH):
        y = y + conv_w[k] * xp[:, k:k + s]
    out = (gate_b * y) @ w_out
    return out, xp[:, -(CONV_WIDTH - 1):]


def squared_relu_mlp(x, w_up, w_down):
    h = jax.nn.relu(x @ w_up)
    return (h * h) @ w_down


def trunk(x, h_re, h_im, conv_buf, norm_mix, norm_mlp, norm_final,
          ssm_a_re, ssm_a_im, ssm_log_dt, ssm_b_re, ssm_b_im, ssm_c_re, ssm_c_im, ssm_d, ssm_w_glu,
          conv_w_in, conv_w, conv_w_out, mlp_w_up, mlp_w_down):
    new_re, new_im, new_buf = [], [], []
    for i in range(DEPTH):
        j = i // N_MIXERS
        hn = rms_norm(x, norm_mix[i])
        if i % N_MIXERS == 0:
            m, hr, hi = s5_mixer(hn, h_re[j], h_im[j], ssm_a_re[j], ssm_a_im[j], ssm_log_dt[j],
                                 ssm_b_re[j], ssm_b_im[j], ssm_c_re[j], ssm_c_im[j], ssm_d[j], ssm_w_glu[j])
            new_re.append(hr)
            new_im.append(hi)
        else:
            m, nb = short_conv_mixer(hn, conv_buf[j], conv_w_in[j], conv_w[j], conv_w_out[j])
            new_buf.append(nb)
        x = x + m
        x = x + squared_relu_mlp(rms_norm(x, norm_mlp[i]), mlp_w_up[i], mlp_w_down[i])
    y = rms_norm(x, norm_final)
    return y, jnp.stack(new_re), jnp.stack(new_im), jnp.stack(new_buf)


def setup_inputs(seed: int = 0) -> dict:
    key = jax.random.key(seed)
    ks = jax.random.split(key, 24)
    f32 = jnp.float32
    n = jnp.arange(STATE_DIM, dtype=f32)
    a_re = -0.5 + 0.01 * jax.random.normal(ks[5], (N_SSM_LAYERS, N_GROUPS, STATE_DIM), f32)
    a_im = math.pi * n + 0.01 * jax.random.normal(ks[6], (N_SSM_LAYERS, N_GROUPS, STATE_DIM), f32)
    log_dt = jax.random.uniform(ks[7], (N_SSM_LAYERS, N_GROUPS), f32, math.log(DT_MIN), math.log(DT_MAX))
    b_scale = (2.0 * GROUP_SIZE) ** -0.5
    c_scale = (2.0 * STATE_DIM) ** -0.5
    return {
        'x_prompt': jax.random.normal(ks[0], (BATCH, SEQ, D_MODEL), f32),
        'x_sample': jax.random.normal(ks[1], (DEC_BATCH, DEC_SEQ, D_MODEL), f32),
        'state_ssm_re': 0.3 * jax.random.normal(ks[2], (N_SSM_LAYERS, DEC_BATCH, N_GROUPS, STATE_DIM), f32),
        'state_ssm_im': 0.3 * jax.random.normal(ks[3], (N_SSM_LAYERS, DEC_BATCH, N_GROUPS, STATE_DIM), f32),
        'state_conv': jax.random.normal(ks[4], (N_CONV_LAYERS, DEC_BATCH, CONV_WIDTH - 1, D_MODEL), f32),
        'norm_mix': 1.0 + 0.02 * jax.random.normal(ks[8], (DEPTH, D_MODEL), f32),
        'norm_mlp': 1.0 + 0.02 * jax.random.normal(ks[9], (DEPTH, D_MODEL), f32),
        'norm_final': 1.0 + 0.02 * jax.random.normal(ks[10], (D_MODEL,), f32),
        'ssm_a_re': a_re,
        'ssm_a_im': a_im,
        'ssm_log_dt': log_dt,
        'ssm_b_re': b_scale * jax.random.normal(ks[11], (N_SSM_LAYERS, N_GROUPS, STATE_DIM, GROUP_SIZE), f32),
        'ssm_b_im': b_scale * jax.random.normal(ks[12], (N_SSM_LAYERS, N_GROUPS, STATE_DIM, GROUP_SIZE), f32),
        'ssm_c_re': c_scale * jax.random.normal(ks[13], (N_SSM_LAYERS, N_GROUPS, GROUP_SIZE, STATE_DIM), f32),
        'ssm_c_im': c_scale * jax.random.normal(ks[14], (N_SSM_LAYERS, N_GROUPS, GROUP_SIZE, STATE_DIM), f32),
        'ssm_d': 1.0 + 0.1 * jax.random.normal(ks[15], (N_SSM_LAYERS, D_MODEL), f32),
        'ssm_w_glu': D_MODEL ** -0.5 * jax.random.normal(ks[16], (N_SSM_LAYERS, D_MODEL, 2 * D_MODEL), f32),
        'conv_w_in': D_MODEL ** -0.5 * jax.random.normal(ks[17], (N_CONV_LAYERS, D_MODEL, 3 * D_MODEL), f32),
        'conv_w': CONV_WIDTH ** -0.5 * jax.random.normal(ks[18], (N_CONV_LAYERS, CONV_WIDTH, D_MODEL), f32),
        'conv_w_out': D_MODEL ** -0.5 * jax.random.normal(ks[19], (N_CONV_LAYERS, D_MODEL, D_MODEL), f32),
        'mlp_w_up': D_MODEL ** -0.5 * jax.random.normal(ks[20], (DEPTH, D_MODEL, D_FF), f32),
        'mlp_w_down': D_FF ** -0.5 * jax.random.normal(ks[21], (DEPTH, D_FF, D_MODEL), f32),
    }


def reference(x_prompt, x_sample, state_ssm_re, state_ssm_im, state_conv, norm_mix, norm_mlp, norm_final,
              ssm_a_re, ssm_a_im, ssm_log_dt, ssm_b_re, ssm_b_im, ssm_c_re, ssm_c_im, ssm_d, ssm_w_glu,
              conv_w_in, conv_w, conv_w_out, mlp_w_up, mlp_w_down):
    zero_re = jnp.zeros((N_SSM_LAYERS, BATCH, N_GROUPS, STATE_DIM), jnp.float32)
    zero_im = jnp.zeros((N_SSM_LAYERS, BATCH, N_GROUPS, STATE_DIM), jnp.float32)
    zero_buf = jnp.zeros((N_CONV_LAYERS, BATCH, CONV_WIDTH - 1, D_MODEL), x_prompt.dtype)
    y_prompt, new_ssm_re_prompt, new_ssm_im_prompt, new_conv_prompt = trunk(
        x_prompt, zero_re, zero_im, zero_buf, norm_mix, norm_mlp, norm_final,
        ssm_a_re, ssm_a_im, ssm_log_dt, ssm_b_re, ssm_b_im, ssm_c_re, ssm_c_im, ssm_d, ssm_w_glu,
        conv_w_in, conv_w, conv_w_out, mlp_w_up, mlp_w_down)
    y_sample, new_ssm_re_sample, new_ssm_im_sample, new_conv_sample = trunk(
        x_sample, state_ssm_re, state_ssm_im, state_conv, norm_mix, norm_mlp, norm_final,
        ssm_a_re, ssm_a_im, ssm_log_dt, ssm_b_re, ssm_b_im, ssm_c_re, ssm_c_im, ssm_d, ssm_w_glu,
        conv_w_in, conv_w, conv_w_out, mlp_w_up, mlp_w_down)
    return (y_prompt, y_sample, new_ssm_re_prompt, new_ssm_im_prompt, new_conv_prompt,
            new_ssm_re_sample, new_ssm_im_sample, new_conv_sample)
```

```cpp
#include <hip/hip_runtime.h>
#include <hip/hip_cooperative_groups.h>
#include <cstdio>
namespace pg8 {
#define PG8_LAS __attribute__((address_space(3)))
typedef unsigned short bf16_t;
typedef short bf16x8 __attribute__((ext_vector_type(8)));
typedef float f32x4 __attribute__((ext_vector_type(4)));
typedef unsigned u32x4 __attribute__((ext_vector_type(4)));
constexpr int BM = 256, BK = 64, HALF = 128, HTB = HALF * BK * 2  , STAGE_BYTES = 8 * HTB, NXCD = 8, WGM = 8;

__host__ __device__ __forceinline__ int lds_byte(int r, int c) { const int st = (r >> 4) * 2 + (c >> 5), rr = r & 15, cc = c & 31, ob = rr * 64 + cc * 2; return st * 1024 + (ob ^ (((ob >> 9) & 1) << 5)); }
__host__ __device__ __forceinline__ void stage_rc(int b, int& R, int& C) { const int st = b / 1024, sb = b % 1024, swz = sb ^ (((sb >> 9) & 1) << 5); R = (st >> 1) * 16 + swz / 64; C = (st & 1) * 32 + (swz % 64) / 2; }
__host__ __device__ __forceinline__ int perm32(int rho) { const int n = rho >> 4, i = rho & 15; return 8 * (i >> 2) + 4 * n + (i & 3); }

struct Unit { int pm, pn; };
struct Gemm { const bf16_t* A; const bf16_t* Bt; int M, N, K; };

struct StaticOrder {
    int nM, nN, nwg, G, c;
    __host__ __device__ void init(int M, int N, int G_, int c_) { nM = M / BM; nN = N / BM; nwg = nM * nN; G = G_; c = c_; }
    __host__ __device__ bool next(int i, Unit& u) const {
        const long L = (long)i * G + c; if (L >= nwg) return false;
        int wgid = (int)L; { const int q = nwg / NXCD, r = nwg % NXCD, xcd = wgid % NXCD, off = wgid / NXCD; wgid = (xcd < r ? xcd * (q + 1) : r * (q + 1) + (xcd - r) * q) + off; }
        const int nig = WGM * nN, gid = wgid / nig, fm = gid * WGM, gsz = (nM - fm) < WGM ? (nM - fm) : WGM;
        u.pm = fm + ((wgid % nig) % gsz); u.pn = (wgid % nig) / gsz; return true;
    }
    __device__ __forceinline__ void a_ready(const Unit&) const {}
    __device__ __forceinline__ void done(const Unit&) const {}
};
struct CountedOrder : StaticOrder {
    const unsigned* ready; unsigned need; unsigned* tmo;
    __device__ __forceinline__ void a_ready(const Unit& u) const {
        if (threadIdx.x < 64) {
            const unsigned long long t0 = __builtin_amdgcn_s_memrealtime(); unsigned polls = 0;
            while ((unsigned)__builtin_amdgcn_readfirstlane(__hip_atomic_load(ready + 64 * u.pm, __ATOMIC_RELAXED, __HIP_MEMORY_SCOPE_AGENT)) < need) {
                if ((++polls & 255u) == 0u && __builtin_amdgcn_readfirstlane(__hip_atomic_load(tmo, __ATOMIC_RELAXED, __HIP_MEMORY_SCOPE_AGENT)) != 0u) break;
                if (__builtin_amdgcn_s_memrealtime() - t0 > 2000000ull) {
                    if (threadIdx.x == 0) { unsigned expect = 0u; __hip_atomic_compare_exchange_strong(tmo + 1, &expect, 0x600u | (unsigned)(u.pm & 0xff), __ATOMIC_RELAXED, __ATOMIC_RELAXED, __HIP_MEMORY_SCOPE_AGENT); __hip_atomic_store(tmo, 1u, __ATOMIC_RELAXED, __HIP_MEMORY_SCOPE_AGENT); }
                    break; }
                __builtin_amdgcn_s_sleep(2); }
            __builtin_amdgcn_fence(__ATOMIC_ACQUIRE, "agent");
            asm volatile("s_waitcnt vmcnt(0)" ::: "memory");
        }
#if !defined(BROKEN_HOOK_NO_BARRIER)
        asm volatile("" ::: "memory"); __builtin_amdgcn_s_barrier(); asm volatile("" ::: "memory");
#endif
    }
};

__device__ __forceinline__ unsigned cvt_pk_bf16(float lo, float hi) { unsigned r; asm volatile("v_cvt_pk_bf16_f32 %0, %1, %2" : "=v"(r) : "v"(lo), "v"(hi)); return r; }
typedef float f32x2 __attribute__((ext_vector_type(2)));
__device__ __forceinline__ f32x2 gelu_pk(f32x2 v) {
    const f32x2 av = __builtin_elementwise_abs(v), d = av * 0.2316418882f + 1.0f;
    f32x2 t; t.x = __builtin_amdgcn_rcpf(d.x); t.y = __builtin_amdgcn_rcpf(d.y);
    f32x2 q = t * 0.5307027145f + (-0.7265760135f); q = q * t + 0.7107068705f; q = q * t + (-0.142248368f); q = q * t + 0.127414796f; q = q * t;
    const f32x2 s = (v * v) * (-0.72134752044f);
    f32x2 e; e.x = __builtin_amdgcn_exp2f(s.x); e.y = __builtin_amdgcn_exp2f(s.y);
    const f32x2 m = v * (q * e), r = v - m;
    f32x2 o; o.x = v.x < 0.f ? m.x : r.x; o.y = v.y < 0.f ? m.y : r.y; return o;
}

constexpr int MPR = 16384, MRR = 16512;
constexpr float RMS_EPS_ = 1e-6f;
typedef unsigned u32x2 __attribute__((ext_vector_type(2)));
__device__ __forceinline__ float sigmoidf_(float z) { return __builtin_amdgcn_rcpf(1.0f + __expf(-z)); }

struct EpiUp {
    static constexpr bool PERM = true, AFTER_DRAIN = false;
    bf16_t* O; int ldc; const unsigned long long* ss;
    __device__ __forceinline__ void operator()(const f32x4 (&acc)[2][2][4][2], const Unit& u, int wr, int wc, int fr, int fq) const {
        const int row0 = u.pm * BM + wr * 64 + fr, col0 = u.pn * BM + wc * 32 + 8 * fq;
#pragma unroll
        for (int ai = 0; ai < 2; ++ai)
#pragma unroll
            for (int m = 0; m < 4; ++m) { const int r = row0 + ai * HALF + m * 16; const float rs = (float)ss[r] * (1.0f / (1024.0f * 1048576.0f)) + RMS_EPS_; const float rs2 = __builtin_amdgcn_rcpf(rs);
                bf16_t* rowp = O + (size_t)r * ldc + col0;
#pragma unroll
                for (int bj = 0; bj < 2; ++bj) { f32x4 v0 = acc[ai][bj][m][0], v1 = acc[ai][bj][m][1];
#pragma unroll
                    for (int j = 0; j < 4; ++j) { const float a = fmaxf(v0[j], 0.f), b = fmaxf(v1[j], 0.f); v0[j] = a * a * rs2; v1[j] = b * b * rs2; }
                    u32x4 w; w.x = cvt_pk_bf16(v0[0], v0[1]); w.y = cvt_pk_bf16(v0[2], v0[3]); w.z = cvt_pk_bf16(v1[0], v1[1]); w.w = cvt_pk_bf16(v1[2], v1[3]);
                    *(u32x4*)(rowp + bj * HALF) = w; } }
    }
};
struct EpiRes {
    static constexpr bool PERM = true, AFTER_DRAIN = false;
    const float* baseP; const float* baseS; float* X; bf16_t* XB; unsigned long long* ss;
    __device__ __forceinline__ void operator()(const f32x4 (&acc)[2][2][4][2], const Unit& u, int wr, int wc, int fr, int fq) const {
        const int row0 = u.pm * BM + wr * 64 + fr, col0 = u.pn * BM + wc * 32 + 8 * fq;
#pragma unroll
        for (int ai = 0; ai < 2; ++ai) { if (u.pm * BM + ai * HALF >= MRR) continue;
#pragma unroll
            for (int m = 0; m < 4; ++m) { const int r = row0 + ai * HALF + m * 16;
                const float* bp = (r < MPR) ? baseP + (size_t)r * 1024 : baseS + (size_t)(r - MPR) * 1024;
                float sq = 0.f;
#pragma unroll
                for (int bj = 0; bj < 2; ++bj) { const int c = col0 + bj * HALF;
                    const f32x4 v0 = acc[ai][bj][m][0] + *(const f32x4*)(bp + c), v1 = acc[ai][bj][m][1] + *(const f32x4*)(bp + c + 4);
                    *(f32x4*)(X + (size_t)r * 1024 + c) = v0; *(f32x4*)(X + (size_t)r * 1024 + c + 4) = v1;
                    u32x4 w; w.x = cvt_pk_bf16(v0[0], v0[1]); w.y = cvt_pk_bf16(v0[2], v0[3]); w.z = cvt_pk_bf16(v1[0], v1[1]); w.w = cvt_pk_bf16(v1[2], v1[3]);
                    *(u32x4*)(XB + (size_t)r * 1024 + c) = w;
                    sq += (v0[0] * v0[0] + v0[1] * v0[1]) + (v0[2] * v0[2] + v0[3] * v0[3]) + (v1[0] * v1[0] + v1[1] * v1[1]) + (v1[2] * v1[2] + v1[3] * v1[3]); }
                sq += __shfl_xor(sq, 16); sq += __shfl_xor(sq, 32);
                if (fq == 0) atomicAdd(ss + r, (unsigned long long)(sq * 1048576.0f + 0.5f)); } }
    }
};
struct EpiGlu {
    static constexpr bool PERM = true, AFTER_DRAIN = false;
    const float* baseP; const float* baseS; float* X; bf16_t* XB; unsigned long long* ss;
    __device__ __forceinline__ void operator()(const f32x4 (&acc)[2][2][4][2], const Unit& u, int wr, int wc, int fr, int fq) const {
        const int row0 = u.pm * BM + wr * 64 + fr, c = u.pn * HALF + wc * 32 + 8 * fq;
#pragma unroll
        for (int ai = 0; ai < 2; ++ai) { if (u.pm * BM + ai * HALF >= MRR) continue;
#pragma unroll
            for (int m = 0; m < 4; ++m) { const int r = row0 + ai * HALF + m * 16;
                const float* bp = (r < MPR) ? baseP + (size_t)r * 1024 : baseS + (size_t)(r - MPR) * 1024;
                f32x4 v0 = *(const f32x4*)(bp + c), v1 = *(const f32x4*)(bp + c + 4);
#pragma unroll
                for (int j = 0; j < 4; ++j) { v0[j] += acc[ai][0][m][0][j] * sigmoidf_(acc[ai][1][m][0][j]); v1[j] += acc[ai][0][m][1][j] * sigmoidf_(acc[ai][1][m][1][j]); }
                *(f32x4*)(X + (size_t)r * 1024 + c) = v0; *(f32x4*)(X + (size_t)r * 1024 + c + 4) = v1;
                u32x4 w; w.x = cvt_pk_bf16(v0[0], v0[1]); w.y = cvt_pk_bf16(v0[2], v0[3]); w.z = cvt_pk_bf16(v1[0], v1[1]); w.w = cvt_pk_bf16(v1[2], v1[3]);
                *(u32x4*)(XB + (size_t)r * 1024 + c) = w;
                float sq = (v0[0] * v0[0] + v0[1] * v0[1]) + (v0[2] * v0[2] + v0[3] * v0[3]) + (v1[0] * v1[0] + v1[1] * v1[1]) + (v1[2] * v1[2] + v1[3] * v1[3]);
                sq += __shfl_xor(sq, 16); sq += __shfl_xor(sq, 32);
                if (fq == 0) atomicAdd(ss + r, (unsigned long long)(sq * 1048576.0f + 0.5f)); } }
    }
};
struct EpiWin {
    static constexpr bool PERM = true, AFTER_DRAIN = false;
    bf16_t* BG; bf16_t* CV; const unsigned long long* ss; float* convP; float* convS;
    __device__ __forceinline__ void operator()(const f32x4 (&acc)[2][2][4][2], const Unit& u, int wr, int wc, int fr, int fq) const {
        const int row0 = u.pm * BM + wr * 64 + fr;
#pragma unroll
        for (int ai = 0; ai < 2; ++ai)
#pragma unroll
            for (int m = 0; m < 4; ++m) { const int r = row0 + ai * HALF + m * 16; const float rs2 = __builtin_amdgcn_rcpf((float)ss[r] * (1.0f / (1024.0f * 1048576.0f)) + RMS_EPS_);
                if (u.pn < 8) { const int c = u.pn * HALF + wc * 32 + 8 * fq;
                    f32x4 v0 = acc[ai][0][m][0] * acc[ai][1][m][0] * rs2, v1 = acc[ai][0][m][1] * acc[ai][1][m][1] * rs2;
                    u32x4 w; w.x = cvt_pk_bf16(v0[0], v0[1]); w.y = cvt_pk_bf16(v0[2], v0[3]); w.z = cvt_pk_bf16(v1[0], v1[1]); w.w = cvt_pk_bf16(v1[2], v1[3]);
                    *(u32x4*)(CV + (size_t)r * 1024 + c) = w;
                    if (r < MPR) { const int t = r & 2047; if (t >= 2046) { float* o = convP + ((size_t)(r >> 11) * 2 + (t - 2046)) * 1024 + c; *(f32x4*)o = v0; *(f32x4*)(o + 4) = v1; } }
                    else if (r < MRR) { float* o = convS + ((size_t)(r - MPR) * 2 + 1) * 1024 + c; *(f32x4*)o = v0; *(f32x4*)(o + 4) = v1; }
                } else { const float rs = __builtin_sqrtf(rs2); const int c = (u.pn - 8) * BM + wc * 32 + 8 * fq;
#pragma unroll
                    for (int bj = 0; bj < 2; ++bj) { const f32x4 v0 = acc[ai][bj][m][0] * rs, v1 = acc[ai][bj][m][1] * rs;
                        u32x4 w; w.x = cvt_pk_bf16(v0[0], v0[1]); w.y = cvt_pk_bf16(v0[2], v0[3]); w.z = cvt_pk_bf16(v1[0], v1[1]); w.w = cvt_pk_bf16(v1[2], v1[3]);
                        *(u32x4*)(BG + (size_t)r * 1024 + c + bj * HALF) = w; } } }
    }
};
template <class Epi, class Sched, bool STAMP = false>
__device__ __forceinline__ void gemm_phase(PG8_LAS unsigned char* lds, const Gemm g, const Sched& S, const Epi& E, unsigned long long* stamps) {
    int tid_ = threadIdx.x; asm volatile("" : "+v"(tid_)); const int tid = tid_, wid = __builtin_amdgcn_readfirstlane(tid >> 6), lane = tid & 63, wr = wid >> 2, wc = wid & 3, fr = lane & 15, fq = lane >> 4;
    const int K = g.K, nt = K / BK;
    int ts_lo = 0, ts_hi = 0, nts = 0; const unsigned long long rt_entry = STAMP ? (unsigned long long)wall_clock64() : 0ull;
#define PG8_STAMP() do { if (STAMP && wid == 0 && nts < 64) { const unsigned long long _c = (unsigned long long)clock64(); \
        ts_lo = (lane == nts) ? (int)(unsigned)_c : ts_lo; ts_hi = (lane == nts) ? (int)(unsigned)(_c >> 32) : ts_hi; ++nts; } } while (0)
    PG8_STAMP();
    unsigned voffA[2], voffB[2];
#pragma unroll
    for (int i = 0; i < 2; ++i) { int R, C; stage_rc(tid * 16 + i * 8192, R, C); const int Rb = Epi::PERM ? ((R & ~31) + perm32(R & 31)) : R;
        voffA[i] = (unsigned)(R * K + C) * 2u; voffB[i] = (unsigned)(Rb * K + C) * 2u; }
    const size_t kstep = (size_t)(BK * 2);
    const size_t hstep = (size_t)HALF * K * 2;
    const size_t tstep = 2 * hstep;
    const unsigned ldsw = (unsigned)wid * 1024u;
    const int aoff = lds_byte(wr * 64 + fr, fq * 8), boff = lds_byte(wc * 32 + fr, fq * 8);
#define PG8_SA(b, h) (((b) * 2 + (h)) * HTB)
#define PG8_SB(b, h) ((4 + (b) * 2 + (h)) * HTB)
#define PG8_STAGE(bufoff, gbase, voff) do { _Pragma("unroll") for (int _i = 0; _i < 2; ++_i) \
        __builtin_amdgcn_global_load_lds((const unsigned*)((const char*)(gbase) + (voff)[_i]), (PG8_LAS unsigned*)(lds + (bufoff) + ldsw + _i * 8192), 16, 0, 0); } while (0)
#define PG8_LDA(dst, b, h) do { _Pragma("unroll") for (int m = 0; m < 4; ++m) _Pragma("unroll") for (int k = 0; k < 2; ++k) dst[m][k] = *(const PG8_LAS bf16x8*)(lds + PG8_SA(b, h) + aoff + m * 2048 + k * 1024); } while (0)
#define PG8_LDB(dst, b, h) do { _Pragma("unroll") for (int n = 0; n < 2; ++n) _Pragma("unroll") for (int k = 0; k < 2; ++k) dst[n][k] = *(const PG8_LAS bf16x8*)(lds + PG8_SB(b, h) + boff + n * 2048 + k * 1024); } while (0)
#define PG8_MMA(ai, bj, At, Bt) do { __builtin_amdgcn_s_setprio(1); _Pragma("unroll") for (int m = 0; m < 4; ++m) _Pragma("unroll") for (int n = 0; n < 2; ++n) _Pragma("unroll") for (int k = 0; k < 2; ++k) \
        acc[ai][bj][m][n] = __builtin_amdgcn_mfma_f32_16x16x32_bf16(Bt[n][k], At[m][k], acc[ai][bj][m][n], 0, 0, 0); __builtin_amdgcn_s_setprio(0); } while (0)
#define PG8_WAIT_V(n) asm volatile("s_waitcnt vmcnt(" #n ")" ::: "memory")
#define PG8_WAIT_L(n) asm volatile("s_waitcnt lgkmcnt(" #n ")" ::: "memory")
#define PG8_BAR __builtin_amdgcn_s_barrier()
#define PG8_SCHED __builtin_amdgcn_sched_barrier(0)
    Unit cur, nxt; int ui = 0;
    if (!S.next(0, cur)) return;
    f32x4 acc[2][2][4][2];
#pragma unroll
    for (int a = 0; a < 2; ++a)
#pragma unroll
        for (int b = 0; b < 2; ++b)
#pragma unroll
            for (int m = 0; m < 4; ++m)
#pragma unroll
                for (int n = 0; n < 2; ++n) acc[a][b][m][n] = (f32x4){0.f, 0.f, 0.f, 0.f};
    bf16x8 At[4][2], B0[2][2], B1[2][2];
    const char* cA = (const char*)g.A + (size_t)cur.pm * tstep; const char* cB = (const char*)g.Bt + (size_t)cur.pn * tstep;
    S.a_ready(cur);
    PG8_STAGE(PG8_SB(0, 0), cB, voffB); PG8_STAGE(PG8_SA(0, 0), cA, voffA); PG8_STAGE(PG8_SB(0, 1), cB + hstep, voffB); PG8_STAGE(PG8_SA(0, 1), cA + hstep, voffA);
    if (wr == 1) PG8_BAR;
    PG8_WAIT_V(4); PG8_BAR;
    PG8_STAGE(PG8_SB(1, 0), cB + kstep, voffB); PG8_STAGE(PG8_SA(1, 0), cA + kstep, voffA); PG8_STAGE(PG8_SB(1, 1), cB + hstep + kstep, voffB);
    PG8_WAIT_V(6); PG8_BAR;
    PG8_STAMP();
    for (;;) {
        const bool has_next = S.next(ui + 1, nxt);
        const char* nA = has_next ? (const char*)g.A + (size_t)nxt.pm * tstep : cA; const char* nB = has_next ? (const char*)g.Bt + (size_t)nxt.pn * tstep : cB;
        for (int t = 0; t < nt; t += 2) {
            const bool last = (t == nt - 2);
            const char* a1 = cA + (size_t)(t + 1) * kstep;
            const char* a2 = last ? nA : cA + (size_t)(t + 2) * kstep; const char* b2 = last ? nB : cB + (size_t)(t + 2) * kstep;
            const char* a3 = a2 + kstep; const char* b3 = b2 + kstep;
            if (last && has_next) S.a_ready(nxt);
            PG8_LDB(B0, 0, 0); PG8_SCHED; PG8_LDA(At, 0, 0); PG8_STAGE(PG8_SA(1, 1), a1 + hstep, voffA);
            PG8_WAIT_L(8); PG8_BAR; PG8_WAIT_L(0); PG8_MMA(0, 0, At, B0); PG8_BAR; PG8_SCHED;
            PG8_LDB(B1, 0, 1); PG8_STAGE(PG8_SB(0, 0), b2, voffB);
            PG8_BAR; PG8_WAIT_L(0); PG8_MMA(0, 1, At, B1); PG8_BAR;
            PG8_LDA(At, 0, 1); PG8_STAGE(PG8_SA(0, 0), a2, voffA);
            PG8_BAR; PG8_WAIT_L(0); PG8_MMA(1, 0, At, B0); PG8_BAR; PG8_SCHED;
            PG8_STAGE(PG8_SB(0, 1), b2 + hstep, voffB);
            PG8_WAIT_V(6); PG8_BAR; PG8_MMA(1, 1, At, B1); PG8_BAR;
            PG8_LDB(B0, 1, 0); PG8_SCHED; PG8_LDA(At, 1, 0); PG8_STAGE(PG8_SA(0, 1), a2 + hstep, voffA);
            PG8_WAIT_L(8); PG8_BAR; PG8_WAIT_L(0); PG8_MMA(0, 0, At, B0); PG8_BAR; PG8_SCHED;
            PG8_LDB(B1, 1, 1); PG8_STAGE(PG8_SB(1, 0), b3, voffB);
            PG8_BAR; PG8_WAIT_L(0); PG8_MMA(0, 1, At, B1); PG8_BAR;
            PG8_LDA(At, 1, 1); PG8_STAGE(PG8_SA(1, 0), a3, voffA);
            PG8_BAR; PG8_WAIT_L(0); PG8_MMA(1, 0, At, B0); PG8_BAR; PG8_SCHED;
            PG8_STAGE(PG8_SB(1, 1), b3 + hstep, voffB);
            PG8_WAIT_V(6); PG8_BAR; PG8_MMA(1, 1, At, B1); PG8_BAR;
        }
        PG8_STAMP();
        if constexpr (!Epi::AFTER_DRAIN) { E(acc, cur, wr, wc, fr, fq); S.done(cur); }
        PG8_STAMP();
        if (!has_next) break;
#pragma unroll
        for (int a = 0; a < 2; ++a)
#pragma unroll
            for (int b = 0; b < 2; ++b)
#pragma unroll
                for (int m = 0; m < 4; ++m)
#pragma unroll
                    for (int n = 0; n < 2; ++n) acc[a][b][m][n] = (f32x4){0.f, 0.f, 0.f, 0.f};
        cur = nxt; cA = nA; cB = nB; ++ui;
    }
    PG8_WAIT_V(0);
    if (wr == 0) PG8_BAR;
    PG8_BAR;
    if constexpr (Epi::AFTER_DRAIN) { E.fused(acc, cur, wr, wc, fr, fq, lds, wid, lane); S.done(cur); }
    PG8_STAMP();
    if (STAMP && wid == 0) { stamps[lane] = lane < nts ? (((unsigned long long)(unsigned)ts_hi << 32) | (unsigned)ts_lo) : 0ull;
        if (lane == 62) stamps[62] = rt_entry; if (lane == 63) stamps[63] = (unsigned long long)wall_clock64(); }
#undef PG8_STAMP
#undef PG8_SA
#undef PG8_SB
#undef PG8_STAGE
#undef PG8_LDA
#undef PG8_LDB
#undef PG8_MMA
#undef PG8_WAIT_V
#undef PG8_WAIT_L
#undef PG8_BAR
#undef PG8_SCHED
}
}

namespace cg = cooperative_groups;
using pg8::bf16_t; using pg8::bf16x8; using pg8::f32x4; using pg8::u32x4; using pg8::cvt_pk_bf16;
typedef float f32x2_t __attribute__((ext_vector_type(2)));

constexpr int D = 1024, FF = 4096, MP = 16384, MS = 128, MR = 16512, MPAD = 16640, NG = 64, NP = 64, NH = 16, RCH = 1024;
constexpr int NTHR = 512;
constexpr float EPS = 1e-6f;
constexpr int LDS_BYTES = pg8::STAGE_BYTES;

constexpr size_t MiB = 1024 * 1024;
constexpr size_t WS_WGLU = 0;
constexpr size_t WS_WUP = WS_WGLU + 8 * MiB;
constexpr size_t WS_WDOWN = WS_WUP + 32 * MiB;
constexpr size_t WS_WIN = WS_WDOWN + 32 * MiB;
constexpr size_t WS_WOUT = WS_WIN + 12 * MiB;
constexpr size_t WS_XB = WS_WOUT + 4 * MiB;
constexpr size_t WS_ACT = WS_XB + (size_t)MPAD * 1024 * 2;
constexpr size_t ACT_BYTES = (size_t)MPAD * 4096 * 2;
constexpr size_t WS_SS = WS_ACT + ACT_BYTES;
constexpr size_t WS_US = WS_SS + 9 * (size_t)MPAD * 8;
constexpr size_t WS_PAR = WS_US + 128 * 1024 * 4;
constexpr size_t PAR_ABAR = 0, PAR_A16 = 32768, PAR_BB = 65536, PAR_CC = 65536 + 524288, PAR_BYTES = 65536 + 2 * 524288;
constexpr size_t WS_END = WS_PAR + PAR_BYTES;
constexpr size_t A_UH = 0;
constexpr size_t A_S = 48 * MiB;
constexpr size_t A_YACT = 80 * MiB;
constexpr size_t A_WG = A_YACT + (size_t)MPAD * 1024 * 2;
constexpr size_t A_TV = A_WG + 4 * MiB;
static_assert(A_TV + 12 * MiB <= ACT_BYTES, "ACT alias overflow");
constexpr size_t A_BG = 0, A_CV = (size_t)MPAD * 1024 * 2, A_Z = 2 * (size_t)MPAD * 1024 * 2;

constexpr size_t O_Y = 0, O_REP = 16908288, O_IMP = 16973824, O_CVP = 17039360, O_RES = 17072128, O_IMS = 18120704, O_CVS = 19169280;

struct Params {
    const float* in[22];
    float* out; unsigned char* ws;
    int ph_lo, ph_hi;
};
typedef const __attribute__((address_space(4))) Params* KP;

__device__ __forceinline__ int tid_opaque() { int t = threadIdx.x; asm volatile("" : "+v"(t)); return t; }
__device__ __forceinline__ float wave_sum(float v) {
#pragma unroll
    for (int o = 32; o >= 1; o >>= 1) v += __shfl_xor(v, o);
    return v;
}
__device__ __forceinline__ float gelu_tanh(float x) {
    const float z = 1.5957691216f * (x + 0.044715f * x * x * x);
    return x * __builtin_amdgcn_rcpf(1.0f + __expf(-z));
}

__device__ __forceinline__ int src_col(int mode, int np) {
    if (mode == 1) { const int pn = np >> 8, h = (np >> 7) & 1, i = np & 127; return h * 1024 + pn * 128 + i; }
    if (mode == 2) { const int pn = np >> 8; if (pn < 8) { const int h = (np >> 7) & 1, i = np & 127; return (1 + h) * 1024 + pn * 128 + i; } return np - 2048; }
    return np;
}
__device__ void transpose_tile(const float* __restrict__ W, bf16_t* __restrict__ Bt, const float* __restrict__ scale, int K, int N, int mode, int tile, float* tl  ) {
    const int tid = tid_opaque(), nkt = K >> 6;
    const int nt = tile / nkt, kt = tile - nt * nkt, k0 = kt << 6, np0 = nt << 6, n0 = src_col(mode, np0);
#pragma unroll
    for (int it = 0; it < 2; ++it) { const int k = it * 32 + (tid >> 4), n4 = (tid & 15) * 4;
        f32x4 v = *(const f32x4*)(W + (size_t)(k0 + k) * N + n0 + n4);
        if (scale) v = v * scale[k0 + k];
        tl[k * 65 + n4] = v[0]; tl[k * 65 + n4 + 1] = v[1]; tl[k * 65 + n4 + 2] = v[2]; tl[k * 65 + n4 + 3] = v[3]; }
    __syncthreads();
    { const int n = tid >> 3, k8 = (tid & 7) * 8; float f[8];
#pragma unroll
      for (int j = 0; j < 8; ++j) f[j] = tl[(k8 + j) * 65 + n];
      u32x4 w; w.x = cvt_pk_bf16(f[0], f[1]); w.y = cvt_pk_bf16(f[2], f[3]); w.z = cvt_pk_bf16(f[4], f[5]); w.w = cvt_pk_bf16(f[6], f[7]);
      *(u32x4*)(Bt + (size_t)(np0 + n) * K + k0 + k8) = w; }
    __syncthreads();
}

__device__ void ssm_gen_unit(KP p, int j, int g, unsigned char* lds) {
    f32x2_t* apow = (f32x2_t*)lds;
    f32x2_t* Bb = apow + 17 * 64;
    f32x2_t* Cc = Bb + 1024;
    float* Kt = (float*)(Cc + 1024);
    const int tid = tid_opaque();
    const float* a_re = p->in[8] + (size_t)(j * NG + g) * NP; const float* a_im = p->in[9] + (size_t)(j * NG + g) * NP;
    const float dt = expf(p->in[10][j * NG + g]);
    unsigned char* act = p->ws + WS_ACT; unsigned char* par = p->ws + WS_PAR;
    if (tid < 64) { const float ar = a_re[tid], ai = a_im[tid];
        for (int tau = 0; tau <= 16; ++tau) { const float x = (float)tau * dt * ar, y = (float)tau * dt * ai; float s, c; sincosf(y, &s, &c); const float e = expf(x); apow[tau * 64 + tid] = (f32x2_t){e * c, e * s}; }
        ((f32x2_t*)(par + PAR_ABAR))[g * 64 + tid] = apow[64 + tid]; ((f32x2_t*)(par + PAR_A16))[g * 64 + tid] = apow[16 * 64 + tid]; }
    for (int i = tid; i < 1024; i += NTHR) { const int pp = i >> 4, h = i & 15;
        const float ar = a_re[pp], ai = a_im[pp]; const float x = dt * ar, y = dt * ai; float s, c, sh, ch; sincosf(y, &s, &c); sincosf(0.5f * y, &sh, &ch);
        const float er = expm1f(x) * c - 2.0f * sh * sh, ei = expf(x) * s;
        const float den = 1.0f / (ar * ar + ai * ai); const float qr = (er * ar + ei * ai) * den, qi = (ei * ar - er * ai) * den;
        const size_t bi = ((size_t)(j * NG + g) * NP + pp) * NH + h; const float br = p->in[11][bi], bim = p->in[12][bi];
        const f32x2_t bb = (f32x2_t){qr * br - qi * bim, qr * bim + qi * br};
        Bb[pp * 16 + h] = bb; ((f32x2_t*)(par + PAR_BB))[((size_t)g * NH + h) * NP + pp] = bb; }
    for (int i = tid; i < 1024; i += NTHR) { const size_t ci = (size_t)(j * NG + g) * 1024 + i; const f32x2_t cc = (f32x2_t){p->in[13][ci], p->in[14][ci]};
        Cc[i] = cc; ((f32x2_t*)(par + PAR_CC))[(size_t)g * 1024 + i] = cc; }
    __syncthreads();
    for (int idx = tid; idx < 4096; idx += NTHR) { const int tau = idx >> 8, ho = (idx >> 4) & 15, hi = idx & 15; float acc = 0.f;
        for (int pp = 0; pp < 64; ++pp) { const f32x2_t c = Cc[ho * 64 + pp], a = apow[tau * 64 + pp], b = Bb[pp * 16 + hi];
            const float car = c.x * a.x - c.y * a.y, cai = c.x * a.y + c.y * a.x; acc += car * b.x - cai * b.y; }
        if (tau == 0 && ho == hi) acc += p->in[15][j * D + g * 16 + ho];
        Kt[idx] = acc; }
    __syncthreads();
    bf16_t* TV = (bf16_t*)(act + A_TV) + (size_t)g * 256 * 384;
    for (int it = tid; it < 4096; it += NTHR) { const int n = it >> 4, s = it & 15, t = n >> 4, ho = n & 15; float f[16];
#pragma unroll
        for (int hi = 0; hi < 16; ++hi) f[hi] = (s <= t) ? Kt[((t - s) * 16 + ho) * 16 + hi] : 0.f;
        u32x4 w0, w1; w0.x = cvt_pk_bf16(f[0], f[1]); w0.y = cvt_pk_bf16(f[2], f[3]); w0.z = cvt_pk_bf16(f[4], f[5]); w0.w = cvt_pk_bf16(f[6], f[7]);
        w1.x = cvt_pk_bf16(f[8], f[9]); w1.y = cvt_pk_bf16(f[10], f[11]); w1.z = cvt_pk_bf16(f[12], f[13]); w1.w = cvt_pk_bf16(f[14], f[15]);
        u32x4* o = (u32x4*)(TV + (size_t)n * 384 + s * 16); o[0] = w0; o[1] = w1; }
    for (int it = tid; it < 4096; it += NTHR) { const int n = it >> 4, p4 = (it & 15) * 4, t = n >> 4, ho = n & 15; float f[8];
#pragma unroll
        for (int q = 0; q < 4; ++q) { const f32x2_t c = Cc[ho * 64 + p4 + q], a = apow[(t + 1) * 64 + p4 + q]; f[2 * q] = c.x * a.x - c.y * a.y; f[2 * q + 1] = -(c.x * a.y + c.y * a.x); }
        u32x4 w; w.x = cvt_pk_bf16(f[0], f[1]); w.y = cvt_pk_bf16(f[2], f[3]); w.z = cvt_pk_bf16(f[4], f[5]); w.w = cvt_pk_bf16(f[6], f[7]);
        *(u32x4*)(TV + (size_t)n * 384 + 256 + 2 * p4) = w; }
    bf16_t* WG = (bf16_t*)(act + A_WG) + (size_t)g * 128 * 256;
    for (int it = tid; it < 2048; it += NTHR) { const int n = it >> 4, s = it & 15, pp = n >> 1, c = n & 1; const f32x2_t a = apow[(15 - s) * 64 + pp]; float f[16];
#pragma unroll
        for (int hi = 0; hi < 16; ++hi) { const f32x2_t b = Bb[pp * 16 + hi]; f[hi] = c ? (a.x * b.y + a.y * b.x) : (a.x * b.x - a.y * b.y); }
        u32x4 w0, w1; w0.x = cvt_pk_bf16(f[0], f[1]); w0.y = cvt_pk_bf16(f[2], f[3]); w0.z = cvt_pk_bf16(f[4], f[5]); w0.w = cvt_pk_bf16(f[6], f[7]);
        w1.x = cvt_pk_bf16(f[8], f[9]); w1.y = cvt_pk_bf16(f[10], f[11]); w1.z = cvt_pk_bf16(f[12], f[13]); w1.w = cvt_pk_bf16(f[14], f[15]);
        u32x4* o = (u32x4*)(WG + (size_t)n * 256 + s * 16); o[0] = w0; o[1] = w1; }
    __syncthreads();
}

__device__ void norm_unit(KP p, const float* srcP, const float* srcS, const float* gain, int unit, unsigned char* lds) {
    const int tid = tid_opaque(), w = tid >> 6, lane = tid & 63;
    bf16_t* tile = (bf16_t*)lds;
    const bool samp = unit >= RCH;
    f32x4 gv[4];
#pragma unroll
    for (int q = 0; q < 4; ++q) gv[q] = *(const f32x4*)(gain + lane * 16 + q * 4);
#pragma unroll
    for (int tt = 0; tt < 2; ++tt) { const int t = w * 2 + tt;
        const float* row = samp ? srcS + (size_t)((unit - RCH) * 16 + t) * D : srcP + (size_t)(unit * 16 + t) * D;
        f32x4 v[4]; float sq = 0.f;
#pragma unroll
        for (int q = 0; q < 4; ++q) { v[q] = *(const f32x4*)(row + lane * 16 + q * 4); sq += (v[q][0] * v[q][0] + v[q][1] * v[q][1]) + (v[q][2] * v[q][2] + v[q][3] * v[q][3]); }
        sq = wave_sum(sq); const float rstd = rsqrtf(sq * (1.0f / 1024.0f) + EPS);
#pragma unroll
        for (int q = 0; q < 4; ++q) v[q] = v[q] * rstd * gv[q];
        if (samp) { float* o = (float*)(p->ws + WS_US) + (size_t)((unit - RCH) * 16 + t) * D + lane * 16;
#pragma unroll
            for (int q = 0; q < 4; ++q) *(f32x4*)(o + q * 4) = v[q]; }
        else { u32x4 w0, w1; w0.x = cvt_pk_bf16(v[0][0], v[0][1]); w0.y = cvt_pk_bf16(v[0][2], v[0][3]); w0.z = cvt_pk_bf16(v[1][0], v[1][1]); w0.w = cvt_pk_bf16(v[1][2], v[1][3]);
            w1.x = cvt_pk_bf16(v[2][0], v[2][1]); w1.y = cvt_pk_bf16(v[2][2], v[2][3]); w1.z = cvt_pk_bf16(v[3][0], v[3][1]); w1.w = cvt_pk_bf16(v[3][2], v[3][3]);
            u32x4* o = (u32x4*)(tile + t * 1024 + lane * 16); o[0] = w0; o[1] = w1; } }
    if (!samp) { __syncthreads();
        bf16_t* UH = (bf16_t*)(p->ws + WS_ACT + A_UH);
#pragma unroll
        for (int i = 0; i < 4; ++i) { const int idx = i * NTHR + tid, g = idx >> 5, q = idx & 31, t = q >> 1, half = q & 1;
            const u32x4 v = *(const u32x4*)(tile + t * 1024 + g * 16 + half * 8);
            *(u32x4*)(UH + ((size_t)g * RCH + unit) * 384 + q * 8) = v; }
        __syncthreads(); }
}

__device__ void g1_unit(KP p, int unit) {
    const int tid = tid_opaque(), w = tid >> 6, lane = tid & 63, fr = lane & 15, fq = lane >> 4, g = unit >> 2, q = unit & 3;
    const bf16_t* WG = (const bf16_t*)(p->ws + WS_ACT + A_WG) + (size_t)g * 128 * 256;
    const bf16_t* UH = (const bf16_t*)(p->ws + WS_ACT + A_UH) + (size_t)g * RCH * 384;
    float* S = (float*)(p->ws + WS_ACT + A_S) + (size_t)g * RCH * 128;
    bf16x8 bfr[8];
#pragma unroll
    for (int ks = 0; ks < 8; ++ks) bfr[ks] = *(const bf16x8*)(WG + (size_t)(w * 16 + fr) * 256 + ks * 32 + fq * 8);
#pragma unroll 2
    for (int rb = 0; rb < 16; ++rb) { const int r = q * 256 + rb * 16 + fr; const bf16_t* ar = UH + (size_t)r * 384 + fq * 8;
        bf16x8 a[8];
#pragma unroll
        for (int ks = 0; ks < 8; ++ks) a[ks] = *(const bf16x8*)(ar + ks * 32);
        f32x4 acc = (f32x4){0.f, 0.f, 0.f, 0.f};
#pragma unroll
        for (int ks = 0; ks < 8; ++ks) acc = __builtin_amdgcn_mfma_f32_16x16x32_bf16(bfr[ks], a[ks], acc, 0, 0, 0);
        *(f32x4*)(S + (size_t)r * 128 + w * 16 + fq * 4) = acc; }
}
__device__ void g2_unit(KP p, int unit) {
    const int tid = tid_opaque(), w = tid >> 6, lane = tid & 63, fr = lane & 15, fq = lane >> 4, g = unit >> 2, q = unit & 3;
    const bf16_t* TV = (const bf16_t*)(p->ws + WS_ACT + A_TV) + (size_t)g * 256 * 384;
    const bf16_t* UH = (const bf16_t*)(p->ws + WS_ACT + A_UH) + (size_t)g * RCH * 384;
    bf16_t* Y = (bf16_t*)(p->ws + WS_ACT + A_YACT);
    bf16x8 bfr[2][12];
#pragma unroll
    for (int nb = 0; nb < 2; ++nb)
#pragma unroll
        for (int ks = 0; ks < 12; ++ks) bfr[nb][ks] = *(const bf16x8*)(TV + (size_t)((2 * w + nb) * 16 + fr) * 384 + ks * 32 + fq * 8);
    for (int rb = 0; rb < 16; ++rb) { const int r = q * 256 + rb * 16 + fr; const bf16_t* ar = UH + (size_t)r * 384 + fq * 8;
        bf16x8 a[12];
#pragma unroll
        for (int ks = 0; ks < 12; ++ks) a[ks] = *(const bf16x8*)(ar + ks * 32);
        f32x4 acc0 = (f32x4){0.f, 0.f, 0.f, 0.f}, acc1 = acc0;
#pragma unroll
        for (int ks = 0; ks < 12; ++ks) { acc0 = __builtin_amdgcn_mfma_f32_16x16x32_bf16(bfr[0][ks], a[ks], acc0, 0, 0, 0); acc1 = __builtin_amdgcn_mfma_f32_16x16x32_bf16(bfr[1][ks], a[ks], acc1, 0, 0, 0); }
        pg8::u32x2 w0, w1; w0.x = cvt_pk_bf16(gelu_tanh(acc0[0]), gelu_tanh(acc0[1])); w0.y = cvt_pk_bf16(gelu_tanh(acc0[2]), gelu_tanh(acc0[3]));
        w1.x = cvt_pk_bf16(gelu_tanh(acc1[0]), gelu_tanh(acc1[1])); w1.y = cvt_pk_bf16(gelu_tanh(acc1[2]), gelu_tanh(acc1[3]));
        *(pg8::u32x2*)(Y + ((size_t)r * 16 + 2 * w) * D + g * 16 + fq * 4) = w0;
        *(pg8::u32x2*)(Y + ((size_t)r * 16 + 2 * w + 1) * D + g * 16 + fq * 4) = w1; }
}
__device__ void scan_unit(KP p, int j, int g) {
    const int tid = tid_opaque(), b = tid >> 6, pp = tid & 63;
    const f32x2_t a16 = ((const f32x2_t*)(p->ws + WS_PAR + PAR_A16))[g * 64 + pp];
    const float* S = (const float*)(p->ws + WS_ACT + A_S) + ((size_t)g * RCH + b * 128) * 128 + 2 * pp;
    bf16_t* H = (bf16_t*)(p->ws + WS_ACT + A_UH) + ((size_t)g * RCH + b * 128) * 384 + 256 + 2 * pp;
    float hr = 0.f, hi = 0.f;
    for (int c0 = 0; c0 < 128; c0 += 8) { f32x2_t s[8];
#pragma unroll
        for (int i = 0; i < 8; ++i) s[i] = *(const f32x2_t*)(S + (size_t)(c0 + i) * 128);
#pragma unroll
        for (int i = 0; i < 8; ++i) { *(unsigned*)(H + (size_t)(c0 + i) * 384) = cvt_pk_bf16(hr, hi);
            const float nr = a16.x * hr - a16.y * hi + s[i].x, ni = a16.x * hi + a16.y * hr + s[i].y; hr = nr; hi = ni; } }
    const size_t oi = (((size_t)j * 8 + b) * NG + g) * NP + pp;
    p->out[O_REP + oi] = hr; p->out[O_IMP + oi] = hi;
}
__device__ void s5_sample_unit(KP p, int j, int unit) {
    const int tid = tid_opaque(), w = tid >> 6, lane = tid & 63, i = unit >> 3, g = (unit & 7) * 8 + w;
    const unsigned char* par = p->ws + WS_PAR;
    const float* u = (const float*)(p->ws + WS_US) + (size_t)i * D + g * 16;
    float uv[16];
#pragma unroll
    for (int q = 0; q < 4; ++q) { const f32x4 t = *(const f32x4*)(u + q * 4); uv[4 * q] = t[0]; uv[4 * q + 1] = t[1]; uv[4 * q + 2] = t[2]; uv[4 * q + 3] = t[3]; }
    const f32x2_t a = ((const f32x2_t*)(par + PAR_ABAR))[g * 64 + lane];
    const size_t si = (((size_t)j * MS + i) * NG + g) * NP + lane;
    const float h0r = p->in[2][si], h0i = p->in[3][si];
    float hr = a.x * h0r - a.y * h0i, hi = a.x * h0i + a.y * h0r;
    const f32x2_t* Bb = (const f32x2_t*)(par + PAR_BB) + (size_t)g * NH * NP + lane;
#pragma unroll
    for (int h = 0; h < 16; ++h) { const f32x2_t b = Bb[h * NP]; hr += b.x * uv[h]; hi += b.y * uv[h]; }
    p->out[O_RES + si] = hr; p->out[O_IMS + si] = hi;
    const f32x2_t* Cc = (const f32x2_t*)(par + PAR_CC) + (size_t)g * 1024 + lane;
    float y = 0.f;
#pragma unroll
    for (int ho = 0; ho < 16; ++ho) { const f32x2_t c = Cc[ho * 64]; const float s = wave_sum(c.x * hr - c.y * hi); if (lane == ho) y = s; }
    if (lane < 16) { const float d = p->in[15][j * D + g * 16 + lane]; float ul = 0.f;
#pragma unroll
        for (int h = 0; h < 16; ++h) ul = (lane == h) ? uv[h] : ul;
        const float v = gelu_tanh(y + d * ul);
        bf16_t* Y = (bf16_t*)(p->ws + WS_ACT + A_YACT) + (size_t)(MP + i) * D + g * 16 + lane;
        *Y = (bf16_t)(cvt_pk_bf16(v, 0.f) & 0xffffu); }
}
__device__ void convgate_unit(KP p, int j, int unit) {
    const int tid = tid_opaque(), r = unit * 4 + (tid >> 7), c = (tid & 127) * 8;
    const bf16_t* BG = (const bf16_t*)(p->ws + WS_ACT + A_BG); const bf16_t* CV = (const bf16_t*)(p->ws + WS_ACT + A_CV); bf16_t* Z = (bf16_t*)(p->ws + WS_ACT + A_Z);
    const float* cw = p->in[18] + (size_t)j * 3 * D + c;
    float x0[8], x1[8], x2[8], bg[8];
    auto unpack = [](const u32x4 v, float* f) { f[0] = __uint_as_float(v.x << 16); f[1] = __uint_as_float(v.x & 0xffff0000u); f[2] = __uint_as_float(v.y << 16); f[3] = __uint_as_float(v.y & 0xffff0000u);
        f[4] = __uint_as_float(v.z << 16); f[5] = __uint_as_float(v.z & 0xffff0000u); f[6] = __uint_as_float(v.w << 16); f[7] = __uint_as_float(v.w & 0xffff0000u); };
    unpack(*(const u32x4*)(CV + (size_t)r * D + c), x2); unpack(*(const u32x4*)(BG + (size_t)r * D + c), bg);
    if (r < MP) { const int t = r & 2047;
        if (t >= 1) unpack(*(const u32x4*)(CV + (size_t)(r - 1) * D + c), x1); else { for (int k = 0; k < 8; ++k) x1[k] = 0.f; }
        if (t >= 2) unpack(*(const u32x4*)(CV + (size_t)(r - 2) * D + c), x0); else { for (int k = 0; k < 8; ++k) x0[k] = 0.f; }
    } else { const int i = r - MP; const float* sb = p->in[4] + (((size_t)j * MS + i) * 2) * D + c; float* so = p->out + O_CVS + (((size_t)j * MS + i) * 2) * D + c;
#pragma unroll
        for (int k = 0; k < 8; ++k) { x0[k] = sb[k]; x1[k] = sb[D + k]; so[k] = x1[k]; } }
    float z[8];
#pragma unroll
    for (int k = 0; k < 8; ++k) z[k] = bg[k] * (cw[k] * x0[k] + cw[D + k] * x1[k] + cw[2 * D + k] * x2[k]);
    u32x4 w; w.x = cvt_pk_bf16(z[0], z[1]); w.y = cvt_pk_bf16(z[2], z[3]); w.z = cvt_pk_bf16(z[4], z[5]); w.w = cvt_pk_bf16(z[6], z[7]);
    *(u32x4*)(Z + (size_t)r * D + c) = w;
}
__device__ void final_unit(KP p, int unit) {
    const int tid = tid_opaque(), r = unit * 4 + (tid >> 7), c = (tid & 127) * 8;
    const unsigned long long* ss = (const unsigned long long*)(p->ws + WS_SS) + 7 * (size_t)MPAD;
    const float rstd = rsqrtf((float)ss[r] * (1.0f / (1024.0f * 1048576.0f)) + EPS);
    float* x = p->out + (size_t)r * D + c; const float* g = p->in[7] + c;
    f32x4 v0 = *(const f32x4*)x, v1 = *(const f32x4*)(x + 4);
    v0 = v0 * rstd * *(const f32x4*)g; v1 = v1 * rstd * *(const f32x4*)(g + 4);
    *(f32x4*)x = v0; *(f32x4*)(x + 4) = v1;
}

__global__ void __launch_bounds__(NTHR) fwd_kernel(Params p_) {
    KP p = (KP)__builtin_amdgcn_kernarg_segment_ptr();
    extern __shared__ __attribute__((aligned(16))) unsigned char lds[];
    cg::grid_group grid = cg::this_grid();
    const int bid = blockIdx.x, G = gridDim.x, tid = threadIdx.x;
    const int ph_lo = p->ph_lo, ph_hi = p->ph_hi;
    for (int ph = ph_lo; ph < ph_hi; ++ph) {
        asm volatile("" : "+s"(p));
        unsigned char* ws = p->ws;
        unsigned long long* SS = (unsigned long long*)(ws + WS_SS);
        bf16_t* XB = (bf16_t*)(ws + WS_XB);
        const int L = (ph - 1) / 12 * 2;
        const int rel = ph == 0 ? 0 : (ph - 1) % 12 + 1;
        const int jj = L >> 1;
        if (ph == 24) {
            for (int u = bid; u < MR / 4; u += G) final_unit(p, u);
        } else if (ph == 0 || ph == 12) {
            const int j = (ph == 0) ? 0 : 1;
            if (ph == 0) {
                for (int i = bid * NTHR + tid_opaque(); i < 9 * MPAD; i += G * NTHR) SS[i] = 0ull;
            }
            {
                for (int u = bid; u < NG; u += G) ssm_gen_unit(p, j, u, lds);
                const float* srcP = (ph == 0) ? p->in[0] : p->out; const float* srcS = (ph == 0) ? p->in[1] : p->out + (size_t)MP * D;
                for (int u = bid; u < RCH + 8; u += G) norm_unit(p, srcP, srcS, p->in[5] + (size_t)(2 * j) * D, u, lds);
            }
            if (ph == 0) {
                for (int jb = 0; jb < 14; ++jb) {
                    const float* W; bf16_t* Bt; const float* sc = nullptr; int K, N, mode = 0;
                    if (jb < 2) { W = p->in[16] + (size_t)jb * 1024 * 2048; Bt = (bf16_t*)(ws + WS_WGLU) + (size_t)jb * 2048 * 1024; K = 1024; N = 2048; mode = 1; }
                    else if (jb < 6) { const int i = jb - 2; W = p->in[20] + (size_t)i * 1024 * 4096; Bt = (bf16_t*)(ws + WS_WUP) + (size_t)i * 4096 * 1024; K = 1024; N = 4096; sc = p->in[6] + (size_t)i * D; }
                    else if (jb < 10) { const int i = jb - 6; W = p->in[21] + (size_t)i * 4096 * 1024; Bt = (bf16_t*)(ws + WS_WDOWN) + (size_t)i * 1024 * 4096; K = 4096; N = 1024; }
                    else if (jb < 12) { const int i = jb - 10; W = p->in[17] + (size_t)i * 1024 * 3072; Bt = (bf16_t*)(ws + WS_WIN) + (size_t)i * 3072 * 1024; K = 1024; N = 3072; mode = 2; sc = p->in[5] + (size_t)(2 * i + 1) * D; }
                    else { const int i = jb - 12; W = p->in[19] + (size_t)i * 1024 * 1024; Bt = (bf16_t*)(ws + WS_WOUT) + (size_t)i * 1024 * 1024; K = 1024; N = 1024; }
                    const int ntiles = (K >> 6) * (N >> 6);
                    for (int t = bid; t < ntiles; t += G) transpose_tile(W, Bt, sc, K, N, mode, t, (float*)lds);
                }
            }
        } else if (rel == 1) {
            for (int u = bid; u < 256; u += G) g1_unit(p, u);
            for (int u = bid; u < MS * 8; u += G) s5_sample_unit(p, jj, u);
        } else if (rel == 2) {
            for (int u = bid; u < NG; u += G) scan_unit(p, jj, u);
        } else if (rel == 3) {
            for (int u = bid; u < 256; u += G) g2_unit(p, u);
        } else if (rel == 8) {
            for (int u = bid; u < MR / 4; u += G) convgate_unit(p, jj, u);
        } else {
            pg8::StaticOrder S; pg8::Gemm g;
            PG8_LAS unsigned char* l3 = (PG8_LAS unsigned char*)lds;
            if (rel == 4) {
                g = pg8::Gemm{(const bf16_t*)(ws + WS_ACT + A_YACT), (const bf16_t*)(ws + WS_WGLU) + (size_t)jj * 2048 * 1024, MPAD, 2048, 1024};
                S.init(MPAD, 2048, G, bid);
                pg8::EpiGlu E{L == 0 ? p->in[0] : p->out, L == 0 ? p->in[1] : p->out + (size_t)MP * D, p->out, XB, SS + (size_t)(L * 2) * MPAD};
                pg8::gemm_phase<pg8::EpiGlu, pg8::StaticOrder>(l3, g, S, E, nullptr);
            } else if (rel == 5 || rel == 10) {
                const int layer = L + (rel == 10), ssi = layer * 2;
                g = pg8::Gemm{XB, (const bf16_t*)(ws + WS_WUP) + (size_t)layer * 4096 * 1024, MPAD, 4096, 1024};
                S.init(MPAD, 4096, G, bid);
                pg8::EpiUp E{(bf16_t*)(ws + WS_ACT), 4096, SS + (size_t)ssi * MPAD};
                pg8::gemm_phase<pg8::EpiUp, pg8::StaticOrder>(l3, g, S, E, nullptr);
            } else if (rel == 6 || rel == 11 || rel == 9) {
                const int layer = L + (rel != 6);
                const int ssi = (rel == 9) ? layer * 2 : layer * 2 + 1;
                if (rel == 9) { g = pg8::Gemm{(const bf16_t*)(ws + WS_ACT + A_Z), (const bf16_t*)(ws + WS_WOUT) + (size_t)jj * 1024 * 1024, MPAD, 1024, 1024}; }
                else { g = pg8::Gemm{(const bf16_t*)(ws + WS_ACT), (const bf16_t*)(ws + WS_WDOWN) + (size_t)layer * 1024 * 4096, MPAD, 1024, 4096}; }
                S.init(MPAD, 1024, G, bid);
                pg8::EpiRes E{p->out, p->out + (size_t)MP * D, p->out, XB, SS + (size_t)ssi * MPAD};
                pg8::gemm_phase<pg8::EpiRes, pg8::StaticOrder>(l3, g, S, E, nullptr);
            } else {
                g = pg8::Gemm{XB, (const bf16_t*)(ws + WS_WIN) + (size_t)jj * 3072 * 1024, MPAD, 3072, 1024};
                S.init(MPAD, 3072, G, bid);
                pg8::EpiWin E{(bf16_t*)(ws + WS_ACT + A_BG), (bf16_t*)(ws + WS_ACT + A_CV), SS + (size_t)(L * 2 + 1) * MPAD, p->out + O_CVP + (size_t)jj * 8 * 2 * D, p->out + O_CVS + (size_t)jj * MS * 2 * D};
                pg8::gemm_phase<pg8::EpiWin, pg8::StaticOrder>(l3, g, S, E, nullptr);
            }
        }
        if (ph + 1 < ph_hi) grid.sync();
    }
}

extern "C" void kernel_launch(void* const* d_in, const int* in_sizes, int n_in, void* d_out, int out_size, void* d_ws, size_t ws_size, hipStream_t stream) {
    static int grid = 0;
    if (grid == 0) {
        if (n_in != 22 || ws_size < WS_END) { fprintf(stderr, "kernel_launch: need 22 inputs and %zu bytes of workspace; got %d, %zu\n", (size_t)WS_END, n_in, ws_size); grid = -1; return; }
        int dev = 0, cus = 0, per_cu = 0;
        hipGetDevice(&dev); hipDeviceGetAttribute(&cus, hipDeviceAttributeMultiprocessorCount, dev);
        if (hipFuncSetAttribute((const void*)fwd_kernel, hipFuncAttributeMaxDynamicSharedMemorySize, LDS_BYTES) != hipSuccess) { fprintf(stderr, "kernel_launch: hipFuncSetAttribute failed\n"); grid = -1; return; }
        if (hipOccupancyMaxActiveBlocksPerMultiprocessor(&per_cu, (const void*)fwd_kernel, NTHR, LDS_BYTES) != hipSuccess || per_cu < 1) { fprintf(stderr, "kernel_launch: occupancy query says %d\n", per_cu); (void)hipGetLastError(); per_cu = 1; }
        grid = cus;
    }
    if (grid < 0) return;
    Params p{};
    for (int i = 0; i < 22; ++i) p.in[i] = (const float*)d_in[i];
    p.out = (float*)d_out; p.ws = (unsigned char*)d_ws;
#if defined(MULTI_LAUNCH)
    for (int ph = 0; ph < 25; ++ph) { p.ph_lo = ph; p.ph_hi = ph + 1; hipLaunchKernelGGL(fwd_kernel, dim3(grid), dim3(NTHR), LDS_BYTES, stream, p); }
#else
    p.ph_lo = 0; p.ph_hi = 25;
    void* args[] = {&p};
    hipError_t e = hipLaunchCooperativeKernel((const void*)fwd_kernel, dim3(grid), dim3(NTHR), args, LDS_BYTES, stream);
    if (e != hipSuccess) fprintf(stderr, "cooperative launch failed: %s (grid %d)\n", hipGetErrorString(e), grid);
#endif
}
```

```cpp
#include <hip/hip_runtime.h>
#include <hip/hip_cooperative_groups.h>
#include <cstdio>
namespace pg8 {
#define PG8_LAS __attribute__((address_space(3)))
typedef unsigned short bf16_t;
typedef short bf16x8 __attribute__((ext_vector_type(8)));
typedef float f32x4 __attribute__((ext_vector_type(4)));
typedef unsigned u32x4 __attribute__((ext_vector_type(4)));
constexpr int BM = 256, BK = 64, HALF = 128, HTB = HALF * BK * 2  , STAGE_BYTES = 8 * HTB, NXCD = 8, WGM = 8;

__host__ __device__ __forceinline__ int lds_byte(int r, int c) { const int st = (r >> 4) * 2 + (c >> 5), rr = r & 15, cc = c & 31, ob = rr * 64 + cc * 2; return st * 1024 + (ob ^ (((ob >> 9) & 1) << 5)); }
__host__ __device__ __forceinline__ void stage_rc(int b, int& R, int& C) { const int st = b / 1024, sb = b % 1024, swz = sb ^ (((sb >> 9) & 1) << 5); R = (st >> 1) * 16 + swz / 64; C = (st & 1) * 32 + (swz % 64) / 2; }
__host__ __device__ __forceinline__ int perm32(int rho) { const int n = rho >> 4, i = rho & 15; return 8 * (i >> 2) + 4 * n + (i & 3); }

struct Unit { int pm, pn; };
struct Gemm { const bf16_t* A; const bf16_t* Bt; int M, N, K; };

struct StaticOrder {
    int nM, nN, nwg, G, c;
    __host__ __device__ void init(int M, int N, int G_, int c_) { nM = M / BM; nN = N / BM; nwg = nM * nN; G = G_; c = c_; }
    __host__ __device__ bool next(int i, Unit& u) const {
        const long L = (long)i * G + c; if (L >= nwg) return false;
        int wgid = (int)L; { const int q = nwg / NXCD, r = nwg % NXCD, xcd = wgid % NXCD, off = wgid / NXCD; wgid = (xcd < r ? xcd * (q + 1) : r * (q + 1) + (xcd - r) * q) + off; }
        const int nig = WGM * nN, gid = wgid / nig, fm = gid * WGM, gsz = (nM - fm) < WGM ? (nM - fm) : WGM;
        u.pm = fm + ((wgid % nig) % gsz); u.pn = (wgid % nig) / gsz; return true;
    }
    __device__ __forceinline__ void a_ready(const Unit&) const {}
    __device__ __forceinline__ void done(const Unit&) const {}
};
struct CountedOrder : StaticOrder {
    const unsigned* ready; unsigned need; unsigned* tmo;
    __device__ __forceinline__ void a_ready(const Unit& u) const {
        if (threadIdx.x < 64) {
            const unsigned long long t0 = __builtin_amdgcn_s_memrealtime(); unsigned polls = 0;
            while ((unsigned)__builtin_amdgcn_readfirstlane(__hip_atomic_load(ready + 64 * u.pm, __ATOMIC_RELAXED, __HIP_MEMORY_SCOPE_AGENT)) < need) {
                if ((++polls & 255u) == 0u && __builtin_amdgcn_readfirstlane(__hip_atomic_load(tmo, __ATOMIC_RELAXED, __HIP_MEMORY_SCOPE_AGENT)) != 0u) break;
                if (__builtin_amdgcn_s_memrealtime() - t0 > 2000000ull) {
                    if (threadIdx.x == 0) { unsigned expect = 0u; __hip_atomic_compare_exchange_strong(tmo + 1, &expect, 0x600u | (unsigned)(u.pm & 0xff), __ATOMIC_RELAXED, __ATOMIC_RELAXED, __HIP_MEMORY_SCOPE_AGENT); __hip_atomic_store(tmo, 1u, __ATOMIC_RELAXED, __HIP_MEMORY_SCOPE_AGENT); }
                    break; }
                __builtin_amdgcn_s_sleep(2); }
            __builtin_amdgcn_fence(__ATOMIC_ACQUIRE, "agent");
            asm volatile("s_waitcnt vmcnt(0)" ::: "memory");
        }
#if !defined(BROKEN_HOOK_NO_BARRIER)
        asm volatile("" ::: "memory"); __builtin_amdgcn_s_barrier(); asm volatile("" ::: "memory");
#endif
    }
};

__device__ __forceinline__ unsigned cvt_pk_bf16(float lo, float hi) { unsigned r; asm volatile("v_cvt_pk_bf16_f32 %0, %1, %2" : "=v"(r) : "v"(lo), "v"(hi)); return r; }
typedef float f32x2 __attribute__((ext_vector_type(2)));
__device__ __forceinline__ f32x2 gelu_pk(f32x2 v) {
    const f32x2 av = __builtin_elementwise_abs(v), d = av * 0.2316418882f + 1.0f;
    f32x2 t; t.x = __builtin_amdgcn_rcpf(d.x); t.y = __builtin_amdgcn_rcpf(d.y);
    f32x2 q = t * 0.5307027145f + (-0.7265760135f); q = q * t + 0.7107068705f; q = q * t + (-0.142248368f); q = q * t + 0.127414796f; q = q * t;
    const f32x2 s = (v * v) * (-0.72134752044f);
    f32x2 e; e.x = __builtin_amdgcn_exp2f(s.x); e.y = __builtin_amdgcn_exp2f(s.y);
    const f32x2 m = v * (q * e), r = v - m;
    f32x2 o; o.x = v.x < 0.f ? m.x : r.x; o.y = v.y < 0.f ? m.y : r.y; return o;
}

constexpr int MPR = 16384, MRR = 16512;
constexpr float RMS_EPS_ = 1e-6f;
typedef unsigned u32x2 __attribute__((ext_vector_type(2)));
__device__ __forceinline__ float sigmoidf_(float z) { return __builtin_amdgcn_rcpf(1.0f + __expf(-z)); }

struct EpiUp {
    static constexpr bool PERM = true, AFTER_DRAIN = false;
    bf16_t* O; int ldc; const unsigned long long* ss;
    __device__ __forceinline__ void operator()(const f32x4 (&acc)[2][2][4][2], const Unit& u, int wr, int wc, int fr, int fq) const {
        const int row0 = u.pm * BM + wr * 64 + fr, col0 = u.pn * BM + wc * 32 + 8 * fq;
        unsigned long long sv[2][4];
#pragma unroll
        for (int ai = 0; ai < 2; ++ai)
#pragma unroll
            for (int m = 0; m < 4; ++m) sv[ai][m] = ss[row0 + ai * HALF + m * 16];
#pragma unroll
        for (int ai = 0; ai < 2; ++ai)
#pragma unroll
            for (int m = 0; m < 4; ++m) { const int r = row0 + ai * HALF + m * 16; const float rs2 = __builtin_amdgcn_rcpf((float)sv[ai][m] * (1.0f / (1024.0f * 1048576.0f)) + RMS_EPS_);
                bf16_t* rowp = O + (size_t)r * ldc + col0;
#pragma unroll
                for (int bj = 0; bj < 2; ++bj) { f32x4 v0 = acc[ai][bj][m][0], v1 = acc[ai][bj][m][1];
#pragma unroll
                    for (int j = 0; j < 4; ++j) { const float a = fmaxf(v0[j], 0.f), b = fmaxf(v1[j], 0.f); v0[j] = a * a * rs2; v1[j] = b * b * rs2; }
                    u32x4 w; w.x = cvt_pk_bf16(v0[0], v0[1]); w.y = cvt_pk_bf16(v0[2], v0[3]); w.z = cvt_pk_bf16(v1[0], v1[1]); w.w = cvt_pk_bf16(v1[2], v1[3]);
                    *(u32x4*)(rowp + bj * HALF) = w; } }
    }
};
struct EpiRes {
    static constexpr bool PERM = true, AFTER_DRAIN = false;
    const float* baseP; const float* baseS; float* X; bf16_t* XB; unsigned long long* ss; int gm;
    __device__ __forceinline__ void operator()(const f32x4 (&acc)[2][2][4][2], const Unit& u, int wr, int wc, int fr, int fq) const {
        const int row0 = u.pm * BM + wr * 64 + fr, col0 = u.pn * BM + wc * 32 + 8 * fq;
#pragma unroll
        for (int ai = 0; ai < 2; ++ai) { if (u.pm * BM + ai * HALF >= MRR) continue;
            f32x4 bv[4][2][2];
#pragma unroll
            for (int m = 0; m < 4; ++m) { const int r = row0 + ai * HALF + m * 16;
                const float* bp = (r < MPR) ? baseP + (size_t)r * 1024 : baseS + (size_t)(r - MPR) * 1024;
#pragma unroll
                for (int bj = 0; bj < 2; ++bj) { bv[m][bj][0] = *(const f32x4*)(bp + col0 + bj * HALF); bv[m][bj][1] = *(const f32x4*)(bp + col0 + bj * HALF + 4); } }
#pragma unroll
            for (int m = 0; m < 4; ++m) { const int r = row0 + ai * HALF + m * 16;
                float sq = 0.f;
#pragma unroll
                for (int bj = 0; bj < 2; ++bj) { const int c = col0 + bj * HALF;
                    const f32x4 v0 = acc[ai][bj][m][0] + bv[m][bj][0], v1 = acc[ai][bj][m][1] + bv[m][bj][1];
                    *(f32x4*)(X + (size_t)r * 1024 + c) = v0; *(f32x4*)(X + (size_t)r * 1024 + c + 4) = v1;
                    u32x4 w; w.x = cvt_pk_bf16(v0[0], v0[1]); w.y = cvt_pk_bf16(v0[2], v0[3]); w.z = cvt_pk_bf16(v1[0], v1[1]); w.w = cvt_pk_bf16(v1[2], v1[3]);
                    if (gm) *(u32x4*)(XB + ((size_t)(c >> 4) * 16640 + r) * 16 + (c & 8)) = w; else *(u32x4*)(XB + (size_t)r * 1024 + c) = w;
                    sq += (v0[0] * v0[0] + v0[1] * v0[1]) + (v0[2] * v0[2] + v0[3] * v0[3]) + (v1[0] * v1[0] + v1[1] * v1[1]) + (v1[2] * v1[2] + v1[3] * v1[3]); }
                sq += __shfl_xor(sq, 16); sq += __shfl_xor(sq, 32);
                if (fq == 0) atomicAdd(ss + r, (unsigned long long)(sq * 1048576.0f + 0.5f)); } }
    }
};
struct EpiResFinal {
    static constexpr bool PERM = true, AFTER_DRAIN = true;
    const float* base; float* out; const float* gain; unsigned long long* ss; unsigned* cnt;
    __device__ __forceinline__ void operator()(const f32x4 (&)[2][2][4][2], const Unit&, int, int, int, int) const {}
    __device__ __forceinline__ void fused(f32x4 (&acc)[2][2][4][2], const Unit& u, int wr, int wc, int fr, int fq, PG8_LAS unsigned char* lds, int wid, int lane) const {
        const int row0 = u.pm * BM + wr * 64 + fr, col0 = u.pn * BM + wc * 32 + 8 * fq;
#pragma unroll
        for (int ai = 0; ai < 2; ++ai) {
            f32x4 bv[4][2][2];
#pragma unroll
            for (int m = 0; m < 4; ++m) { const float* bp = base + (size_t)(row0 + ai * HALF + m * 16) * 1024;
#pragma unroll
                for (int bj = 0; bj < 2; ++bj) { bv[m][bj][0] = *(const f32x4*)(bp + col0 + bj * HALF); bv[m][bj][1] = *(const f32x4*)(bp + col0 + bj * HALF + 4); } }
#pragma unroll
            for (int m = 0; m < 4; ++m) { const int r = row0 + ai * HALF + m * 16; float sq = 0.f;
#pragma unroll
                for (int bj = 0; bj < 2; ++bj) { const f32x4 v0 = acc[ai][bj][m][0] + bv[m][bj][0], v1 = acc[ai][bj][m][1] + bv[m][bj][1]; acc[ai][bj][m][0] = v0; acc[ai][bj][m][1] = v1;
                    sq += (v0[0] * v0[0] + v0[1] * v0[1]) + (v0[2] * v0[2] + v0[3] * v0[3]) + (v1[0] * v1[0] + v1[1] * v1[1]) + (v1[2] * v1[2] + v1[3] * v1[3]); }
                sq += __shfl_xor(sq, 16); sq += __shfl_xor(sq, 32);
                if (fq == 0) atomicAdd(ss + r, (unsigned long long)(sq * 1048576.0f + 0.5f)); } }
        asm volatile("s_waitcnt vmcnt(0)" ::: "memory");
        __builtin_amdgcn_s_barrier();
        if (wid == 0 && lane == 0) {
            __hip_atomic_fetch_add(cnt + 64 * u.pm, 1u, __ATOMIC_RELAXED, __HIP_MEMORY_SCOPE_AGENT);
            unsigned sp = 0;
            while (__hip_atomic_load(cnt + 64 * u.pm, __ATOMIC_RELAXED, __HIP_MEMORY_SCOPE_AGENT) < 4u) { __builtin_amdgcn_s_sleep(2); if (++sp > (1u << 22)) break; }
        }
        asm volatile("s_waitcnt vmcnt(0) lgkmcnt(0)" ::: "memory");
        __builtin_amdgcn_s_barrier();
        asm volatile("" ::: "memory");
        f32x4 g[2][2];
#pragma unroll
        for (int bj = 0; bj < 2; ++bj) { g[bj][0] = *(const f32x4*)(gain + col0 + bj * HALF); g[bj][1] = *(const f32x4*)(gain + col0 + bj * HALF + 4); }
        unsigned long long sv[2][4];
#pragma unroll
        for (int ai = 0; ai < 2; ++ai)
#pragma unroll
            for (int m = 0; m < 4; ++m) sv[ai][m] = __hip_atomic_load(ss + row0 + ai * HALF + m * 16, __ATOMIC_RELAXED, __HIP_MEMORY_SCOPE_AGENT);
#pragma unroll
        for (int ai = 0; ai < 2; ++ai)
#pragma unroll
            for (int m = 0; m < 4; ++m) { const int r = row0 + ai * HALF + m * 16; const float rstd = rsqrtf((float)sv[ai][m] * (1.0f / (1024.0f * 1048576.0f)) + RMS_EPS_);
#pragma unroll
                for (int bj = 0; bj < 2; ++bj) { float* o = out + (size_t)r * 1024 + col0 + bj * HALF;
                    *(f32x4*)o = acc[ai][bj][m][0] * rstd * g[bj][0]; *(f32x4*)(o + 4) = acc[ai][bj][m][1] * rstd * g[bj][1]; } }
    }
};
struct EpiGlu {
    static constexpr bool PERM = true, AFTER_DRAIN = false;
    const float* baseP; const float* baseS; float* X; bf16_t* XB; unsigned long long* ss;
    __device__ __forceinline__ void operator()(const f32x4 (&acc)[2][2][4][2], const Unit& u, int wr, int wc, int fr, int fq) const {
        const int row0 = u.pm * BM + wr * 64 + fr, c = u.pn * HALF + wc * 32 + 8 * fq;
        f32x4 bv[2][4][2];
#pragma unroll
        for (int ai = 0; ai < 2; ++ai)
#pragma unroll
            for (int m = 0; m < 4; ++m) { const int r = row0 + ai * HALF + m * 16;
                const float* bp = (r < MPR) ? baseP + (size_t)r * 1024 : baseS + (size_t)(r - MPR) * 1024;
                bv[ai][m][0] = *(const f32x4*)(bp + c); bv[ai][m][1] = *(const f32x4*)(bp + c + 4); }
#pragma unroll
        for (int ai = 0; ai < 2; ++ai)
#pragma unroll
            for (int m = 0; m < 4; ++m) { const int r = row0 + ai * HALF + m * 16;
                f32x4 v0 = bv[ai][m][0], v1 = bv[ai][m][1];
#pragma unroll
                for (int j = 0; j < 4; ++j) { v0[j] += acc[ai][0][m][0][j] * sigmoidf_(acc[ai][1][m][0][j]); v1[j] += acc[ai][0][m][1][j] * sigmoidf_(acc[ai][1][m][1][j]); }
                *(f32x4*)(X + (size_t)r * 1024 + c) = v0; *(f32x4*)(X + (size_t)r * 1024 + c + 4) = v1;
                u32x4 w; w.x = cvt_pk_bf16(v0[0], v0[1]); w.y = cvt_pk_bf16(v0[2], v0[3]); w.z = cvt_pk_bf16(v1[0], v1[1]); w.w = cvt_pk_bf16(v1[2], v1[3]);
                *(u32x4*)(XB + (size_t)r * 1024 + c) = w;
                float sq = (v0[0] * v0[0] + v0[1] * v0[1]) + (v0[2] * v0[2] + v0[3] * v0[3]) + (v1[0] * v1[0] + v1[1] * v1[1]) + (v1[2] * v1[2] + v1[3] * v1[3]);
                sq += __shfl_xor(sq, 16); sq += __shfl_xor(sq, 32);
                if (fq == 0) atomicAdd(ss + r, (unsigned long long)(sq * 1048576.0f + 0.5f)); }
    }
};
struct EpiWin {
    static constexpr bool PERM = true, AFTER_DRAIN = false;
    bf16_t* BG; bf16_t* CV; const unsigned long long* ss; float* convP; float* convS;
    __device__ __forceinline__ void operator()(const f32x4 (&acc)[2][2][4][2], const Unit& u, int wr, int wc, int fr, int fq) const {
        const int row0 = u.pm * BM + wr * 64 + fr;
        unsigned long long sv[2][4];
#pragma unroll
        for (int ai = 0; ai < 2; ++ai)
#pragma unroll
            for (int m = 0; m < 4; ++m) sv[ai][m] = ss[row0 + ai * HALF + m * 16];
#pragma unroll
        for (int ai = 0; ai < 2; ++ai)
#pragma unroll
            for (int m = 0; m < 4; ++m) { const int r = row0 + ai * HALF + m * 16; const float rs2 = __builtin_amdgcn_rcpf((float)sv[ai][m] * (1.0f / (1024.0f * 1048576.0f)) + RMS_EPS_);
                if (u.pn < 8) { const int c = u.pn * HALF + wc * 32 + 8 * fq;
                    f32x4 v0 = acc[ai][0][m][0] * acc[ai][1][m][0] * rs2, v1 = acc[ai][0][m][1] * acc[ai][1][m][1] * rs2;
                    u32x4 w; w.x = cvt_pk_bf16(v0[0], v0[1]); w.y = cvt_pk_bf16(v0[2], v0[3]); w.z = cvt_pk_bf16(v1[0], v1[1]); w.w = cvt_pk_bf16(v1[2], v1[3]);
                    *(u32x4*)(CV + (size_t)r * 1024 + c) = w;
                    if (r < MPR) { const int t = r & 2047; if (t >= 2046) { float* o = convP + ((size_t)(r >> 11) * 2 + (t - 2046)) * 1024 + c; *(f32x4*)o = v0; *(f32x4*)(o + 4) = v1; } }
                    else if (r < MRR) { float* o = convS + ((size_t)(r - MPR) * 2 + 1) * 1024 + c; *(f32x4*)o = v0; *(f32x4*)(o + 4) = v1; }
                } else { const float rs = __builtin_sqrtf(rs2); const int c = (u.pn - 8) * BM + wc * 32 + 8 * fq;
#pragma unroll
                    for (int bj = 0; bj < 2; ++bj) { const f32x4 v0 = acc[ai][bj][m][0] * rs, v1 = acc[ai][bj][m][1] * rs;
                        u32x4 w; w.x = cvt_pk_bf16(v0[0], v0[1]); w.y = cvt_pk_bf16(v0[2], v0[3]); w.z = cvt_pk_bf16(v1[0], v1[1]); w.w = cvt_pk_bf16(v1[2], v1[3]);
                        *(u32x4*)(BG + (size_t)r * 1024 + c + bj * HALF) = w; } } }
    }
};
template <class Epi, class Sched, bool ALIGN_EPI = false, bool SP2 = false>
__device__ __forceinline__ void gemm_phase(PG8_LAS unsigned char* lds, const Gemm g, const Sched& S, const Epi& E) {
    int tid_ = threadIdx.x; asm volatile("" : "+v"(tid_)); const int tid = tid_, wid = __builtin_amdgcn_readfirstlane(tid >> 6), lane = tid & 63, wr = wid >> 2, wc = wid & 3, fr = lane & 15, fq = lane >> 4;
    const int K = g.K, nt = K / BK;
    unsigned voffA[2], voffB[2];
#pragma unroll
    for (int i = 0; i < 2; ++i) { int R, C; stage_rc(tid * 16 + i * 8192, R, C); const int Rb = Epi::PERM ? ((R & ~31) + perm32(R & 31)) : R;
        voffA[i] = (unsigned)(R * K + C) * 2u; voffB[i] = (unsigned)(Rb * K + C) * 2u; }
    const size_t kstep = (size_t)(BK * 2);
    const size_t hstep = (size_t)HALF * K * 2;
    const size_t tstep = 2 * hstep;
    const unsigned ldsw = (unsigned)wid * 1024u;
    const int aoff = lds_byte(wr * 64 + fr, fq * 8), boff = lds_byte(wc * 32 + fr, fq * 8);
#define PG8_SA(b, h) (((b) * 2 + (h)) * HTB)
#define PG8_SB(b, h) ((4 + (b) * 2 + (h)) * HTB)
#define PG8_STAGE(bufoff, gbase, voff) do { _Pragma("unroll") for (int _i = 0; _i < 2; ++_i) \
        __builtin_amdgcn_global_load_lds((const unsigned*)((const char*)(gbase) + (voff)[_i]), (PG8_LAS unsigned*)(lds + (bufoff) + ldsw + _i * 8192), 16, 0, 0); } while (0)
#define PG8_LDA(dst, b, h) do { _Pragma("unroll") for (int m = 0; m < 4; ++m) _Pragma("unroll") for (int k = 0; k < 2; ++k) dst[m][k] = *(const PG8_LAS bf16x8*)(lds + PG8_SA(b, h) + aoff + m * 2048 + k * 1024); } while (0)
#define PG8_LDB(dst, b, h) do { _Pragma("unroll") for (int n = 0; n < 2; ++n) _Pragma("unroll") for (int k = 0; k < 2; ++k) dst[n][k] = *(const PG8_LAS bf16x8*)(lds + PG8_SB(b, h) + boff + n * 2048 + k * 1024); } while (0)
#define PG8_MMA(ai, bj, At, Bt) do { __builtin_amdgcn_s_setprio(1); _Pragma("unroll") for (int m = 0; m < 4; ++m) _Pragma("unroll") for (int n = 0; n < 2; ++n) _Pragma("unroll") for (int k = 0; k < 2; ++k) \
        acc[ai][bj][m][n] = __builtin_amdgcn_mfma_f32_16x16x32_bf16(Bt[n][k], At[m][k], acc[ai][bj][m][n], 0, 0, 0); __builtin_amdgcn_s_setprio(0); } while (0)
#define PG8_WAIT_V(n) asm volatile("s_waitcnt vmcnt(" #n ")" ::: "memory")
#define PG8_WAIT_L(n) asm volatile("s_waitcnt lgkmcnt(" #n ")" ::: "memory")
#define PG8_BAR __builtin_amdgcn_s_barrier()
#define PG8_SCHED __builtin_amdgcn_sched_barrier(0)
    Unit cur, nxt; int ui = 0;
    if (!S.next(0, cur)) return;
    f32x4 acc[2][2][4][2];
#pragma unroll
    for (int a = 0; a < 2; ++a)
#pragma unroll
        for (int b = 0; b < 2; ++b)
#pragma unroll
            for (int m = 0; m < 4; ++m)
#pragma unroll
                for (int n = 0; n < 2; ++n) acc[a][b][m][n] = (f32x4){0.f, 0.f, 0.f, 0.f};
    bf16x8 At[4][2], B0[2][2], B1[2][2];
    const char* cA = (const char*)g.A + (size_t)cur.pm * tstep; const char* cB = (const char*)g.Bt + (size_t)cur.pn * tstep;
    S.a_ready(cur);
    if constexpr (SP2) {
        PG8_STAGE(PG8_SB(0, 0), cB, voffB); PG8_STAGE(PG8_SB(0, 1), cB + hstep, voffB); PG8_STAGE(PG8_SA(0, 0), cA, voffA); PG8_STAGE(PG8_SA(0, 1), cA + hstep, voffA);
        if (wr == 1) PG8_BAR;
        PG8_WAIT_V(2); PG8_BAR;
        PG8_STAGE(PG8_SB(1, 0), cB + kstep, voffB); PG8_STAGE(PG8_SA(1, 0), cA + kstep, voffA); PG8_STAGE(PG8_SB(1, 1), cB + hstep + kstep, voffB);
        PG8_WAIT_V(6); PG8_BAR;
    } else {
        PG8_STAGE(PG8_SB(0, 0), cB, voffB); PG8_STAGE(PG8_SA(0, 0), cA, voffA); PG8_STAGE(PG8_SB(0, 1), cB + hstep, voffB); PG8_STAGE(PG8_SA(0, 1), cA + hstep, voffA);
        if (wr == 1) PG8_BAR;
        PG8_WAIT_V(4); PG8_BAR;
        PG8_STAGE(PG8_SB(1, 0), cB + kstep, voffB); PG8_STAGE(PG8_SA(1, 0), cA + kstep, voffA); PG8_STAGE(PG8_SB(1, 1), cB + hstep + kstep, voffB);
        PG8_WAIT_V(6); PG8_BAR;
    }
    for (;;) {
        const bool has_next = S.next(ui + 1, nxt);
        const char* nA = has_next ? (const char*)g.A + (size_t)nxt.pm * tstep : cA; const char* nB = has_next ? (const char*)g.Bt + (size_t)nxt.pn * tstep : cB;
        for (int t = 0; t < nt; t += 2) {
            const bool last = (t == nt - 2);
            const char* a1 = cA + (size_t)(t + 1) * kstep;
            const char* a2 = last ? nA : cA + (size_t)(t + 2) * kstep; const char* b2 = last ? nB : cB + (size_t)(t + 2) * kstep;
            const char* a3 = a2 + kstep; const char* b3 = b2 + kstep;
            if (last && has_next) S.a_ready(nxt);
            if constexpr (SP2) {
            PG8_LDB(B0, 0, 0); PG8_LDB(B1, 0, 1); PG8_SCHED; PG8_LDA(At, 0, 0); PG8_STAGE(PG8_SA(1, 1), a1 + hstep, voffA);
            PG8_WAIT_V(8); PG8_WAIT_L(0); PG8_BAR; PG8_MMA(0, 0, At, B0); PG8_MMA(0, 1, At, B1); PG8_BAR; PG8_SCHED;
            PG8_LDA(At, 0, 1); PG8_STAGE(PG8_SB(0, 0), b2, voffB); PG8_STAGE(PG8_SB(0, 1), b2 + hstep, voffB); PG8_STAGE(PG8_SA(0, 0), a2, voffA);
            PG8_WAIT_V(8); PG8_WAIT_L(0); PG8_BAR; PG8_MMA(1, 0, At, B0); PG8_MMA(1, 1, At, B1); PG8_BAR; PG8_SCHED;
            PG8_LDB(B0, 1, 0); PG8_LDB(B1, 1, 1); PG8_SCHED; PG8_LDA(At, 1, 0); PG8_STAGE(PG8_SA(0, 1), a2 + hstep, voffA);
            PG8_WAIT_V(8); PG8_WAIT_L(0); PG8_BAR; PG8_MMA(0, 0, At, B0); PG8_MMA(0, 1, At, B1); PG8_BAR; PG8_SCHED;
            PG8_LDA(At, 1, 1); PG8_STAGE(PG8_SB(1, 0), b3, voffB); PG8_STAGE(PG8_SB(1, 1), b3 + hstep, voffB); PG8_STAGE(PG8_SA(1, 0), a3, voffA);
            PG8_WAIT_V(8); PG8_WAIT_L(0); PG8_BAR; PG8_MMA(1, 0, At, B0); PG8_MMA(1, 1, At, B1); PG8_BAR; PG8_SCHED;
            } else {
            PG8_LDB(B0, 0, 0); PG8_SCHED; PG8_LDA(At, 0, 0); PG8_STAGE(PG8_SA(1, 1), a1 + hstep, voffA);
            PG8_WAIT_L(8); PG8_BAR; PG8_WAIT_L(0); PG8_MMA(0, 0, At, B0); PG8_BAR; PG8_SCHED;
            PG8_LDB(B1, 0, 1); PG8_STAGE(PG8_SB(0, 0), b2, voffB);
            PG8_BAR; PG8_WAIT_L(0); PG8_MMA(0, 1, At, B1); PG8_BAR;
            PG8_LDA(At, 0, 1); PG8_STAGE(PG8_SA(0, 0), a2, voffA);
            PG8_BAR; PG8_WAIT_L(0); PG8_MMA(1, 0, At, B0); PG8_BAR; PG8_SCHED;
            PG8_STAGE(PG8_SB(0, 1), b2 + hstep, voffB);
            PG8_WAIT_V(6); PG8_BAR; PG8_MMA(1, 1, At, B1); PG8_BAR;
            PG8_LDB(B0, 1, 0); PG8_SCHED; PG8_LDA(At, 1, 0); PG8_STAGE(PG8_SA(0, 1), a2 + hstep, voffA);
            PG8_WAIT_L(8); PG8_BAR; PG8_WAIT_L(0); PG8_MMA(0, 0, At, B0); PG8_BAR; PG8_SCHED;
            PG8_LDB(B1, 1, 1); PG8_STAGE(PG8_SB(1, 0), b3, voffB);
            PG8_BAR; PG8_WAIT_L(0); PG8_MMA(0, 1, At, B1); PG8_BAR;
            PG8_LDA(At, 1, 1); PG8_STAGE(PG8_SA(1, 0), a3, voffA);
            PG8_BAR; PG8_WAIT_L(0); PG8_MMA(1, 0, At, B0); PG8_BAR; PG8_SCHED;
            PG8_STAGE(PG8_SB(1, 1), b3 + hstep, voffB);
            PG8_WAIT_V(6); PG8_BAR; PG8_MMA(1, 1, At, B1); PG8_BAR;
            }
        }
        if constexpr (ALIGN_EPI) { if (wr == 0) PG8_BAR; }
        if constexpr (!Epi::AFTER_DRAIN) { E(acc, cur, wr, wc, fr, fq); S.done(cur); }
        if (!has_next) break;
#pragma unroll
        for (int a = 0; a < 2; ++a)
#pragma unroll
            for (int b = 0; b < 2; ++b)
#pragma unroll
                for (int m = 0; m < 4; ++m)
#pragma unroll
                    for (int n = 0; n < 2; ++n) acc[a][b][m][n] = (f32x4){0.f, 0.f, 0.f, 0.f};
        cur = nxt; cA = nA; cB = nB; ++ui;
        if constexpr (ALIGN_EPI) { if (wr == 1) PG8_BAR; }
    }
    PG8_WAIT_V(0);
    if constexpr (!ALIGN_EPI) { if (wr == 0) PG8_BAR; }
    PG8_BAR;
    if constexpr (Epi::AFTER_DRAIN) { E.fused(acc, cur, wr, wc, fr, fq, lds, wid, lane); S.done(cur); }
#undef PG8_SA
#undef PG8_SB
#undef PG8_STAGE
#undef PG8_LDA
#undef PG8_LDB
#undef PG8_MMA
#undef PG8_WAIT_V
#undef PG8_WAIT_L
#undef PG8_BAR
#undef PG8_SCHED
}
}

namespace cg = cooperative_groups;
#ifndef GEMM_SP2
#define GEMM_SP2 true
#endif
#ifndef GEMM_ALIGN
#define GEMM_ALIGN true
#endif
using pg8::bf16_t; using pg8::bf16x8; using pg8::f32x4; using pg8::u32x4; using pg8::cvt_pk_bf16;
typedef float f32x2_t __attribute__((ext_vector_type(2)));

constexpr int D = 1024, FF = 4096, MP = 16384, MS = 128, MR = 16512, MPAD = 16640, NG = 64, NP = 64, NH = 16, RCH = 1024;
constexpr int NTHR = 512;
constexpr float EPS = 1e-6f;

constexpr size_t MiB = 1024 * 1024;
__host__ __device__ constexpr size_t W_GLU(int j) { return j == 0 ? 0 : 20 * MiB; }
__host__ __device__ constexpr size_t W_UP(int i) { return i == 0 ? 4 * MiB : (24 + 8 * (size_t)(i - 1)) * MiB; }
__host__ __device__ constexpr size_t W_DOWN(int i) { return i == 0 ? 12 * MiB : (48 + 8 * (size_t)(i - 1)) * MiB; }
__host__ __device__ constexpr size_t W_IN(int j) { return (72 + 6 * (size_t)j) * MiB; }
__host__ __device__ constexpr size_t W_OUT(int j) { return (84 + 2 * (size_t)j) * MiB; }
constexpr size_t WS_XB = 88 * MiB;
constexpr size_t WS_ACT = WS_XB + (size_t)MPAD * 1024 * 2;
constexpr size_t ACT_BYTES = (size_t)MPAD * 4096 * 2;
constexpr size_t WS_SS = WS_ACT + ACT_BYTES;
constexpr size_t WS_US = WS_SS + 9 * (size_t)MPAD * 8;
constexpr size_t WS_PAR = WS_US + 4096;
constexpr size_t PAR_ABAR = 0, PAR_A16 = 32768, PAR_BB = 65536, PAR_CC = 65536 + 524288, PAR_BYTES = 65536 + 2 * 524288;
constexpr size_t WS_BAR = WS_PAR + 2 * PAR_BYTES;
constexpr size_t WS_CNT = WS_BAR + 16384;
constexpr size_t WS_END = WS_CNT + 16384;
constexpr size_t A_YACT = 0;
constexpr size_t A_WG = 40 * MiB;
constexpr size_t A_TV = 44 * MiB;
constexpr size_t A_BG = 0, A_CV = (size_t)MPAD * 1024 * 2, A_Z = 2 * (size_t)MPAD * 1024 * 2;
constexpr size_t WS_WG1 = 0, WS_TV1 = 4 * MiB;
constexpr int USTR = 528, LDS_S = 128 * USTR, LDS_TOTAL = 2 * 128 * USTR;
static_assert(LDS_TOTAL >= pg8::STAGE_BYTES, "LDS");

constexpr size_t O_Y = 0, O_REP = 16908288, O_IMP = 16973824, O_CVP = 17039360, O_RES = 17072128, O_IMS = 18120704, O_CVS = 19169280;

struct Params {
    const float* in[22];
    float* out; unsigned char* ws;
    int ph_lo, ph_hi;
};
typedef const __attribute__((address_space(4))) Params* KP;


#define XB_TMO      128
#define XB_XCNT(j)  (256  + 64 * (j))
#define XB_XSUB(j)  (1280 + 64 * (j))
#define XB_XGEN(j)  (2304 + 64 * (j))
#define XB_TOP      3328
#define XB_TOPGEN   3392
#define XCD_BAR_WORDS 3456
#define XB_SPIN_CAP (1u << 18)
#define LAS __attribute__((address_space(3)))
__device__ __forceinline__ unsigned xb_ld(unsigned* p)              { return __hip_atomic_load(p, __ATOMIC_RELAXED, __HIP_MEMORY_SCOPE_AGENT); }
__device__ __forceinline__ unsigned xb_add(unsigned* p, unsigned v) { return __hip_atomic_fetch_add(p, v, __ATOMIC_RELAXED, __HIP_MEMORY_SCOPE_AGENT); }
__device__ __forceinline__ unsigned xb_xcc_id() { return (unsigned)__builtin_amdgcn_s_getreg((3 << 11) | 20) & 0xFu; }
#define XB_SPIN(cond, bar) do { unsigned _sp = 0; while (cond) { __builtin_amdgcn_s_sleep(1); \
    if ((++_sp & 255u) == 0u) { if (xb_ld(&(bar)[XB_TMO])) break; if (_sp > XB_SPIN_CAP) { atomicAdd(&(bar)[XB_TMO], 1u); break; } } } } while (0)
struct XcdBarrier { unsigned* bar; unsigned x; volatile LAS unsigned* st; };
__device__ __forceinline__ XcdBarrier xcd_barrier_post(unsigned* bar, volatile LAS unsigned* st) {
    XcdBarrier b; b.bar = bar; b.x = xb_xcc_id(); b.st = st;
    if (threadIdx.x == 0) (void)xb_add(&bar[XB_XCNT(b.x)], 1u);
    return b;
}
__device__ __forceinline__ void xcd_barrier_complete(unsigned* bar, unsigned x, unsigned& nloc, unsigned& nx) {
    const unsigned G = gridDim.x * gridDim.y * gridDim.z;
    unsigned sum, cnt, mine, sp = 0u;
    for (;;) {
        sum = 0u; cnt = 0u; mine = 0u;
#pragma unroll
        for (unsigned j = 0; j < 16; ++j) { const unsigned c = xb_ld(&bar[XB_XCNT(j)]); sum += c; cnt += (c > 0u) ? 1u : 0u; mine = (j == x) ? c : mine; }
        if (sum == G) break;
        __builtin_amdgcn_s_sleep(1);
        if ((++sp & 255u) == 0u) { if (xb_ld(&bar[XB_TMO])) break; if (sp > XB_SPIN_CAP) { atomicAdd(&bar[XB_TMO], 1u); break; } }
    }
    nloc = mine > 0u ? mine : 1u; nx = cnt > 0u ? cnt : 1u;
}
__device__ __forceinline__ void xcd_barrier(const XcdBarrier& b) {
    asm volatile("s_waitcnt vmcnt(0)" ::: "memory");
    __syncthreads();
    if (threadIdx.x == 0) {
        unsigned* bar = b.bar;
        __builtin_amdgcn_s_waitcnt(0);
        unsigned nloc = b.st[0], nx = b.st[1];
        if (nloc == 0u) { xcd_barrier_complete(bar, b.x, nloc, nx); b.st[0] = nloc; b.st[1] = nx; }
        const unsigned old = xb_add(&bar[XB_XSUB(b.x)], 1u);
        const unsigned gen = old / nloc;
        if (old + 1u == (gen + 1u) * nloc) {
            __builtin_amdgcn_fence(__ATOMIC_RELEASE, "agent");
            asm volatile("s_waitcnt vmcnt(0)" ::: "memory");
            const unsigned og = xb_add(&bar[XB_TOP], 1u);
            const unsigned tg = og / nx;
            if (og + 1u == (tg + 1u) * nx) xb_add(&bar[XB_TOPGEN], 1u);
            else XB_SPIN(xb_ld(&bar[XB_TOPGEN]) == tg, bar);
            __builtin_amdgcn_fence(__ATOMIC_ACQUIRE, "agent");
            xb_add(&bar[XB_XGEN(b.x)], 1u);
            asm volatile("s_waitcnt vmcnt(0)" ::: "memory");
        } else {
            XB_SPIN(xb_ld(&bar[XB_XGEN(b.x)]) == gen, bar);
            __builtin_amdgcn_fence(__ATOMIC_ACQUIRE, "agent");
            asm volatile("s_waitcnt vmcnt(0)" ::: "memory");
        }
    }
    __syncthreads();
}

__device__ __forceinline__ int tid_opaque() { int t = threadIdx.x; asm volatile("" : "+v"(t)); return t; }
__device__ __forceinline__ float wave_sum(float v) {
#pragma unroll
    for (int o = 32; o >= 1; o >>= 1) v += __shfl_xor(v, o);
    return v;
}
__device__ __forceinline__ float gelu_tanh(float x) {
    const float z = 1.5957691216f * (x + 0.044715f * x * x * x);
    return x * __builtin_amdgcn_rcpf(1.0f + __expf(-z));
}

__device__ __forceinline__ int src_col(int mode, int np) {
    if (mode == 1) { const int pn = np >> 8, h = (np >> 7) & 1, i = np & 127; return h * 1024 + pn * 128 + i; }
    if (mode == 2) { const int pn = np >> 8; if (pn < 8) { const int h = (np >> 7) & 1, i = np & 127; return (1 + h) * 1024 + pn * 128 + i; } return np - 2048; }
    return np;
}
__device__ void transpose_job(const float* __restrict__ W, bf16_t* __restrict__ Bt, const float* __restrict__ scale, int K, int N, int mode, int first, int stride, int nunits, float* tl  ) {
    const int tid = tid_opaque(), nkt = K >> 6;
    const int kk0 = tid >> 4, n4 = (tid & 15) * 4;
    f32x4 v[4][2], vn[4][2];
    auto issue = [&](int unit, f32x4 (&d)[4][2]) {
#pragma unroll
        for (int q = 0; q < 4; ++q) { const int tile = unit * 4 + q, nt = tile / nkt, kt = tile - nt * nkt, k0 = kt << 6, n0 = src_col(mode, nt << 6);
#pragma unroll
            for (int it = 0; it < 2; ++it) d[q][it] = *(const f32x4*)(W + (size_t)(k0 + it * 32 + kk0) * N + n0 + n4); } };
    if (first < nunits) issue(first, v);
    for (int unit = first; unit < nunits; unit += stride) {
        const bool more = unit + stride < nunits;
        if (more) issue(unit + stride, vn);
#pragma unroll
        for (int q = 0; q < 4; ++q) { const int tile = unit * 4 + q, nt = tile / nkt, kt = tile - nt * nkt, k0 = kt << 6;
#pragma unroll
            for (int it = 0; it < 2; ++it) { const int kk = it * 32 + kk0; f32x4 x = v[q][it]; if (scale) x = x * scale[k0 + kk];
                float* t = tl + q * 4160 + kk * 65 + n4; t[0] = x[0]; t[1] = x[1]; t[2] = x[2]; t[3] = x[3]; } }
        __syncthreads();
#pragma unroll
        for (int q = 0; q < 4; ++q) { const int tile = unit * 4 + q, nt = tile / nkt, kt = tile - nt * nkt, k0 = kt << 6, np0 = nt << 6;
            const int n = tid >> 3, k8 = (tid & 7) * 8; float f[8];
#pragma unroll
            for (int j = 0; j < 8; ++j) f[j] = tl[q * 4160 + (k8 + j) * 65 + n];
            u32x4 w; w.x = cvt_pk_bf16(f[0], f[1]); w.y = cvt_pk_bf16(f[2], f[3]); w.z = cvt_pk_bf16(f[4], f[5]); w.w = cvt_pk_bf16(f[6], f[7]);
            *(u32x4*)(Bt + (size_t)(np0 + n) * K + k0 + k8) = w; }
        __syncthreads();
        if (more) {
#pragma unroll
            for (int q = 0; q < 4; ++q) { v[q][0] = vn[q][0]; v[q][1] = vn[q][1]; } }
    }
}

__device__ void ssm_gen_unit(KP p, int j, int part, unsigned char* lds, bf16_t* WGm, bf16_t* TVm, unsigned char* par) {
    f32x2_t* apow = (f32x2_t*)lds;
    f32x2_t* Bb = apow + 17 * 64;
    f32x2_t* Cc = Bb + 1024;
    float* Kt = (float*)(Cc + 1024);
    f32x2_t* qf = (f32x2_t*)(Kt + 4096);
    const int tid = tid_opaque(), g = part >> 2, q = part & 3;
    const float* a_re = p->in[8] + (size_t)(j * NG + g) * NP; const float* a_im = p->in[9] + (size_t)(j * NG + g) * NP;
    const float dt = expf(p->in[10][j * NG + g]);
    for (int idx = tid; idx < 17 * 64 + 64; idx += NTHR) {
        if (idx < 17 * 64) { const int tau = idx >> 6, pp = idx & 63; const float x = (float)tau * dt * a_re[pp], y = (float)tau * dt * a_im[pp]; float s, c; sincosf(y, &s, &c); const float e = expf(x);
            const f32x2_t v = (f32x2_t){e * c, e * s}; apow[idx] = v;
            if (q == 0 && tau == 1) ((f32x2_t*)(par + PAR_ABAR))[g * 64 + pp] = v;
            if (q == 0 && tau == 16) ((f32x2_t*)(par + PAR_A16))[g * 64 + pp] = v; }
        else { const int pp = idx - 17 * 64; const float ar = a_re[pp], ai = a_im[pp]; const float x = dt * ar, y = dt * ai; float s, c, sh, ch; sincosf(y, &s, &c); sincosf(0.5f * y, &sh, &ch);
            const float er = expm1f(x) * c - 2.0f * sh * sh, ei = expf(x) * s;
            const float den = 1.0f / (ar * ar + ai * ai); qf[pp] = (f32x2_t){(er * ar + ei * ai) * den, (ei * ar - er * ai) * den}; } }
    for (int i = tid; i < 1024; i += NTHR) { const size_t ci = (size_t)(j * NG + g) * 1024 + i; const f32x2_t cc = (f32x2_t){p->in[13][ci], p->in[14][ci]};
        Cc[i] = cc; if (q == 0) ((f32x2_t*)(par + PAR_CC))[(size_t)g * 1024 + i] = cc; }
    __syncthreads();
    for (int i = tid; i < 1024; i += NTHR) { const int pp = i >> 4, h = i & 15; const f32x2_t qq = qf[pp];
        const size_t bi = ((size_t)(j * NG + g) * NP + pp) * NH + h; const float br = p->in[11][bi], bim = p->in[12][bi];
        const f32x2_t bb = (f32x2_t){qq.x * br - qq.y * bim, qq.x * bim + qq.y * br};
        Bb[pp * 16 + h] = bb; if (q == 0) ((f32x2_t*)(par + PAR_BB))[((size_t)g * NH + h) * NP + pp] = bb; }
    __syncthreads();
    for (int i2 = tid; i2 < 1024; i2 += NTHR) { const int tau = i2 >> 6, ho = 4 * q + ((i2 >> 4) & 3), hi = i2 & 15; float acc = 0.f;
        for (int pp = 0; pp < 64; ++pp) { const f32x2_t c = Cc[ho * 64 + pp], a = apow[tau * 64 + pp], b = Bb[pp * 16 + hi];
            const float car = c.x * a.x - c.y * a.y, cai = c.x * a.y + c.y * a.x; acc += car * b.x - cai * b.y; }
        if (tau == 0 && ho == hi) acc += p->in[15][j * D + g * 16 + ho];
        Kt[(tau * 16 + ho) * 16 + hi] = acc; }
    __syncthreads();
    bf16_t* TV = TVm + (size_t)g * 256 * 384;
    for (int it = tid; it < 1024; it += NTHR) { const int s = it & 15, ho = 4 * q + ((it >> 4) & 3), t = it >> 6, n = t * 16 + ho; float f[16];
#pragma unroll
        for (int hi = 0; hi < 16; ++hi) f[hi] = (s <= t) ? Kt[((t - s) * 16 + ho) * 16 + hi] : 0.f;
        u32x4 w0, w1; w0.x = cvt_pk_bf16(f[0], f[1]); w0.y = cvt_pk_bf16(f[2], f[3]); w0.z = cvt_pk_bf16(f[4], f[5]); w0.w = cvt_pk_bf16(f[6], f[7]);
        w1.x = cvt_pk_bf16(f[8], f[9]); w1.y = cvt_pk_bf16(f[10], f[11]); w1.z = cvt_pk_bf16(f[12], f[13]); w1.w = cvt_pk_bf16(f[14], f[15]);
        u32x4* o = (u32x4*)(TV + (size_t)n * 384 + s * 16); o[0] = w0; o[1] = w1; }
    for (int it = tid; it < 1024; it += NTHR) { const int p4 = (it & 15) * 4, ho = 4 * q + ((it >> 4) & 3), t = it >> 6, n = t * 16 + ho; float f[8];
#pragma unroll
        for (int r = 0; r < 4; ++r) { const f32x2_t c = Cc[ho * 64 + p4 + r], a = apow[(t + 1) * 64 + p4 + r]; f[2 * r] = c.x * a.x - c.y * a.y; f[2 * r + 1] = -(c.x * a.y + c.y * a.x); }
        u32x4 w; w.x = cvt_pk_bf16(f[0], f[1]); w.y = cvt_pk_bf16(f[2], f[3]); w.z = cvt_pk_bf16(f[4], f[5]); w.w = cvt_pk_bf16(f[6], f[7]);
        *(u32x4*)(TV + (size_t)n * 384 + 256 + 2 * p4) = w; }
    bf16_t* WG = WGm + (size_t)g * 128 * 256;
    { const int n = 32 * q + (tid >> 4), s = tid & 15, pp = n >> 1, c = n & 1; const f32x2_t a = apow[(15 - s) * 64 + pp]; float f[16];
#pragma unroll
        for (int hi = 0; hi < 16; ++hi) { const f32x2_t b = Bb[pp * 16 + hi]; f[hi] = c ? (a.x * b.y + a.y * b.x) : (a.x * b.x - a.y * b.y); }
        u32x4 w0, w1; w0.x = cvt_pk_bf16(f[0], f[1]); w0.y = cvt_pk_bf16(f[2], f[3]); w0.z = cvt_pk_bf16(f[4], f[5]); w0.w = cvt_pk_bf16(f[6], f[7]);
        w1.x = cvt_pk_bf16(f[8], f[9]); w1.y = cvt_pk_bf16(f[10], f[11]); w1.z = cvt_pk_bf16(f[12], f[13]); w1.w = cvt_pk_bf16(f[14], f[15]);
        u32x4* o = (u32x4*)(WG + (size_t)n * 256 + s * 16); o[0] = w0; o[1] = w1; }
    __syncthreads();
}

__device__ void rowss_unit(KP p, int unit, unsigned char* lds) {
    const int tid = tid_opaque(), w = tid >> 6, lane = tid & 63;
    unsigned long long* ss = (unsigned long long*)(p->ws + WS_SS) + 8 * (size_t)MPAD;
    bf16_t* tile = (bf16_t*)lds;
    f32x4 v[2][4];
#pragma unroll
    for (int tt = 0; tt < 2; ++tt) { const int r = unit * 16 + w * 2 + tt; const float* row = (r < MP) ? p->in[0] + (size_t)r * D : p->in[1] + (size_t)(r - MP) * D;
#pragma unroll
        for (int q = 0; q < 4; ++q) v[tt][q] = *(const f32x4*)(row + lane * 16 + q * 4); }
#pragma unroll
    for (int tt = 0; tt < 2; ++tt) { float sq = 0.f;
#pragma unroll
        for (int q = 0; q < 4; ++q) sq += (v[tt][q][0] * v[tt][q][0] + v[tt][q][1] * v[tt][q][1]) + (v[tt][q][2] * v[tt][q][2] + v[tt][q][3] * v[tt][q][3]);
        sq = wave_sum(sq);
        if (lane == 0) ss[unit * 16 + w * 2 + tt] = (unsigned long long)(sq * 1048576.0f + 0.5f);
        u32x4 w0, w1; w0.x = cvt_pk_bf16(v[tt][0][0], v[tt][0][1]); w0.y = cvt_pk_bf16(v[tt][0][2], v[tt][0][3]); w0.z = cvt_pk_bf16(v[tt][1][0], v[tt][1][1]); w0.w = cvt_pk_bf16(v[tt][1][2], v[tt][1][3]);
        w1.x = cvt_pk_bf16(v[tt][2][0], v[tt][2][1]); w1.y = cvt_pk_bf16(v[tt][2][2], v[tt][2][3]); w1.z = cvt_pk_bf16(v[tt][3][0], v[tt][3][1]); w1.w = cvt_pk_bf16(v[tt][3][2], v[tt][3][3]);
        u32x4* o = (u32x4*)(tile + (w * 2 + tt) * 1024 + lane * 16); o[0] = w0; o[1] = w1; }
    if (unit * 16 < MP) {
        __syncthreads();
        bf16_t* XG = (bf16_t*)(p->ws + WS_XB);
#pragma unroll
        for (int i = 0; i < 4; ++i) { const int idx = i * NTHR + tid, g = idx >> 5, q = idx & 31, t = q >> 1, half = q & 1;
            const u32x4 x = *(const u32x4*)(tile + t * 1024 + g * 16 + half * 8);
            *(u32x4*)(XG + ((size_t)g * MPAD + unit * 16) * 16 + q * 8) = x; }
        __syncthreads(); }
}

__device__ void s5_unit(KP p, int j, int g, int b0, const bf16_t* WGm, const bf16_t* TVm, const unsigned char* par, const bf16_t* XG, const unsigned long long* ssrc, const float* gain, unsigned char* lds) {
    const int tid = tid_opaque(), w = __builtin_amdgcn_readfirstlane(tid >> 6), lane = tid & 63, fr = lane & 15, fq = lane >> 4;
    const bf16_t* WG = WGm + (size_t)g * 128 * 256; const bf16_t* TV = TVm + (size_t)g * 256 * 384;
    const float SSC = 1.0f / (1024.0f * 1048576.0f);
    const int t0 = w, t1 = 15 - w, kmax0 = t0 >> 1, kmax1 = t1 >> 1;
    bf16x8 tf0[12], tf1[12];
#pragma unroll
    for (int ks = 0; ks < 12; ++ks) { tf0[ks] = *(const bf16x8*)(TV + (size_t)(t0 * 16 + fr) * 384 + ks * 32 + fq * 8); tf1[ks] = *(const bf16x8*)(TV + (size_t)(t1 * 16 + fr) * 384 + ks * 32 + fq * 8); }
  for (int b = b0; b < b0 + 2; ++b) {
    float* rt = (float*)(lds + LDS_S);
#pragma unroll
    for (int i = 0; i < 4; ++i) { const int tok = i * NTHR + tid; rt[tok] = rsqrtf((float)ssrc[b * 2048 + tok] * SSC + EPS); }
    u32x4 xv[8];
    { const bf16_t* xs = XG + ((size_t)g * MPAD + (size_t)b * 2048) * 16;
#pragma unroll
      for (int i = 0; i < 8; ++i) xv[i] = *(const u32x4*)(xs + (size_t)(i * NTHR + tid) * 8); }
    const f32x4 gv0 = *(const f32x4*)(gain + g * 16 + (tid & 1) * 8), gv1 = *(const f32x4*)(gain + g * 16 + (tid & 1) * 8 + 4);
    __syncthreads();
#pragma unroll
    for (int i = 0; i < 8; ++i) { const int idx = i * NTHR + tid, tok = idx >> 1, half = idx & 1; const float r = rt[tok]; const u32x4 x = xv[i];
        f32x4 a, c; a[0] = __uint_as_float(x.x << 16); a[1] = __uint_as_float(x.x & 0xffff0000u); a[2] = __uint_as_float(x.y << 16); a[3] = __uint_as_float(x.y & 0xffff0000u);
        c[0] = __uint_as_float(x.z << 16); c[1] = __uint_as_float(x.z & 0xffff0000u); c[2] = __uint_as_float(x.w << 16); c[3] = __uint_as_float(x.w & 0xffff0000u);
        a = a * r * gv0; c = c * r * gv1;
        u32x4 o; o.x = cvt_pk_bf16(a[0], a[1]); o.y = cvt_pk_bf16(a[2], a[3]); o.z = cvt_pk_bf16(c[0], c[1]); o.w = cvt_pk_bf16(c[2], c[3]);
        *(u32x4*)(lds + (tok >> 4) * USTR + ((tok & 15) * 16 + half * 8) * 2) = o; }
    bf16x8 wfr[8];
#pragma unroll
    for (int ks = 0; ks < 8; ++ks) wfr[ks] = *(const bf16x8*)(WG + (size_t)(w * 16 + fr) * 256 + ks * 32 + fq * 8);
    __syncthreads();
#pragma unroll 2
    for (int rb = 0; rb < 8; ++rb) { const unsigned char* arow = lds + (rb * 16 + fr) * USTR + fq * 16;
        f32x4 acc = (f32x4){0.f, 0.f, 0.f, 0.f};
#pragma unroll
        for (int ks = 0; ks < 8; ++ks) acc = __builtin_amdgcn_mfma_f32_16x16x32_bf16(wfr[ks], *(const bf16x8*)(arow + ks * 64), acc, 0, 0, 0);
        *(f32x4*)(lds + LDS_S + (rb * 16 + fr) * USTR + (16 * w + 4 * fq) * 4) = acc; }
    __syncthreads();
    {
        const f32x2_t a16 = ((const f32x2_t*)(par + PAR_A16))[g * 64 + lane];
        f32x2_t* tot = (f32x2_t*)(lds + LDS_TOTAL + 16);
        f32x2_t sv[16];
#pragma unroll
        for (int i = 0; i < 16; ++i) sv[i] = *(const f32x2_t*)(lds + LDS_S + (16 * w + i) * USTR + lane * 8);
        float lr = 0.f, li = 0.f, er[16], ei[16];
#pragma unroll
        for (int i = 0; i < 16; ++i) { er[i] = lr; ei[i] = li; const float nr = a16.x * lr - a16.y * li + sv[i].x, ni = a16.x * li + a16.y * lr + sv[i].y; lr = nr; li = ni; }
        tot[w * 64 + lane] = (f32x2_t){lr, li};
        float qr = a16.x, qi = a16.y;
#pragma unroll
        for (int t = 0; t < 4; ++t) { const float nr = qr * qr - qi * qi, ni = 2.0f * qr * qi; qr = nr; qi = ni; }
        __syncthreads();
        float gr = 0.f, gi = 0.f;
        for (int v = 0; v < w; ++v) { const f32x2_t tv = tot[v * 64 + lane]; const float nr = qr * gr - qi * gi + tv.x, ni = qr * gi + qi * gr + tv.y; gr = nr; gi = ni; }
        float pr = 1.f, pi = 0.f;
#pragma unroll
        for (int i = 0; i < 16; ++i) { const float hr = pr * gr - pi * gi + er[i], hi = pr * gi + pi * gr + ei[i];
            *(unsigned*)(lds + LDS_S + (16 * w + i) * USTR + lane * 4) = cvt_pk_bf16(hr, hi);
            const float nr = pr * a16.x - pi * a16.y, ni = pr * a16.y + pi * a16.x; pr = nr; pi = ni; }
        if (w == 7) { const float hr = pr * gr - pi * gi + lr, hi = pr * gi + pi * gr + li;
            const size_t oi = (((size_t)j * 8 + b) * NG + g) * NP + lane;
            p->out[O_REP + oi] = hr; p->out[O_IMP + oi] = hi; }
    }
    __syncthreads();
    bf16_t* Y = (bf16_t*)(p->ws + WS_ACT + A_YACT);
#pragma unroll 1
    for (int rb = 0; rb < 8; ++rb) { const int c = rb * 16 + fr; const unsigned char* arow = lds + c * USTR + fq * 16; const unsigned char* hrow = lds + LDS_S + c * USTR + fq * 16;
        f32x4 acc0 = (f32x4){0.f, 0.f, 0.f, 0.f}, acc1 = acc0;
#pragma unroll
        for (int ks = 0; ks < 8; ++ks) { if (ks <= kmax1) { const bf16x8 a = *(const bf16x8*)(arow + ks * 64);
                acc1 = __builtin_amdgcn_mfma_f32_16x16x32_bf16(tf1[ks], a, acc1, 0, 0, 0);
                if (ks <= kmax0) acc0 = __builtin_amdgcn_mfma_f32_16x16x32_bf16(tf0[ks], a, acc0, 0, 0, 0); } }
#pragma unroll
        for (int ks = 0; ks < 4; ++ks) { const bf16x8 a = *(const bf16x8*)(hrow + ks * 64);
            acc0 = __builtin_amdgcn_mfma_f32_16x16x32_bf16(tf0[8 + ks], a, acc0, 0, 0, 0); acc1 = __builtin_amdgcn_mfma_f32_16x16x32_bf16(tf1[8 + ks], a, acc1, 0, 0, 0); }
        pg8::u32x2 w0, w1; w0.x = cvt_pk_bf16(gelu_tanh(acc0[0]), gelu_tanh(acc0[1])); w0.y = cvt_pk_bf16(gelu_tanh(acc0[2]), gelu_tanh(acc0[3]));
        w1.x = cvt_pk_bf16(gelu_tanh(acc1[0]), gelu_tanh(acc1[1])); w1.y = cvt_pk_bf16(gelu_tanh(acc1[2]), gelu_tanh(acc1[3]));
        const size_t tokb = (size_t)b * 2048 + (size_t)c * 16;
        *(pg8::u32x2*)(Y + (tokb + t0) * D + g * 16 + fq * 4) = w0;
        *(pg8::u32x2*)(Y + (tokb + t1) * D + g * 16 + fq * 4) = w1; }
    __syncthreads();
  }
}
__device__ void s5_sample_wg(KP p, int j, int wgu, const unsigned char* par, const float* srcS, const unsigned long long* ssrcS, const float* gain) {
    const int tid = tid_opaque(), w = tid >> 6, lane = tid & 63, i0 = wgu >> 3, g = (wgu & 7) * 8 + w;
    f32x4 uq[4][4]; unsigned long long ssv[4]; float h0r[4], h0i[4];
#pragma unroll
    for (int s = 0; s < 4; ++s) { const int i = i0 + 32 * s; const float* u = srcS + (size_t)i * D + g * 16;
#pragma unroll
        for (int q = 0; q < 4; ++q) uq[s][q] = *(const f32x4*)(u + q * 4);
        ssv[s] = ssrcS[i]; const size_t si = (((size_t)j * MS + i) * NG + g) * NP + lane; h0r[s] = p->in[2][si]; h0i[s] = p->in[3][si]; }
    f32x4 gq[4];
#pragma unroll
    for (int q = 0; q < 4; ++q) gq[q] = *(const f32x4*)(gain + g * 16 + q * 4);
    const f32x2_t a = ((const f32x2_t*)(par + PAR_ABAR))[g * 64 + lane];
    f32x2_t Bb[16], Cc[16];
#pragma unroll
    for (int h = 0; h < 16; ++h) { Bb[h] = ((const f32x2_t*)(par + PAR_BB))[((size_t)g * NH + h) * NP + lane]; Cc[h] = ((const f32x2_t*)(par + PAR_CC))[(size_t)g * 1024 + h * 64 + lane]; }
    const float d = (lane < 16) ? p->in[15][j * D + g * 16 + lane] : 0.f;
#pragma unroll
    for (int s = 0; s < 4; ++s) { const int i = i0 + 32 * s;
        const float rstd = rsqrtf((float)ssv[s] * (1.0f / (1024.0f * 1048576.0f)) + EPS);
        float uv[16];
#pragma unroll
        for (int q = 0; q < 4; ++q) { const f32x4 t = uq[s][q] * rstd * gq[q]; uv[4 * q] = t[0]; uv[4 * q + 1] = t[1]; uv[4 * q + 2] = t[2]; uv[4 * q + 3] = t[3]; }
        float hr = a.x * h0r[s] - a.y * h0i[s], hi = a.x * h0i[s] + a.y * h0r[s];
#pragma unroll
        for (int h = 0; h < 16; ++h) { hr += Bb[h].x * uv[h]; hi += Bb[h].y * uv[h]; }
        const size_t si = (((size_t)j * MS + i) * NG + g) * NP + lane;
        p->out[O_RES + si] = hr; p->out[O_IMS + si] = hi;
        float y = 0.f;
#pragma unroll
        for (int ho = 0; ho < 16; ++ho) { const float sm = wave_sum(Cc[ho].x * hr - Cc[ho].y * hi); if (lane == ho) y = sm; }
        if (lane < 16) { float ul = 0.f;
#pragma unroll
            for (int h = 0; h < 16; ++h) ul = (lane == h) ? uv[h] : ul;
            const float v = gelu_tanh(y + d * ul);
            bf16_t* Y = (bf16_t*)(p->ws + WS_ACT + A_YACT) + (size_t)(MP + i) * D + g * 16 + lane;
            *Y = (bf16_t)(cvt_pk_bf16(v, 0.f) & 0xffffu); } }
}

enum { SK_UP = 0, SK_RES = 1, SK_GLU = 2, SK_WIN = 3 };
struct SkArgs { const bf16_t* A; const bf16_t* Bt; int K;
    bf16_t* O;
    const float* baseS; float* X; bf16_t* XB; unsigned long long* ssw;
    const unsigned long long* ssr;
    bf16_t* BG; bf16_t* CV; float* convS; };
template <int MODE>
__device__ __forceinline__ int sk2_brow(int cg, int cb, int i) {
    if (MODE == SK_UP) return 128 * cg + 16 * cb + i;
    if (MODE == SK_RES) return 32 * cg + 16 * cb + i;
    const int sel = cb >> 1, c = 32 * cg + 16 * (cb & 1) + i;
    if (MODE == SK_GLU) return 256 * (c >> 7) + 128 * sel + (c & 127);
    return sel < 2 ? 256 * (c >> 7) + 128 * sel + (c & 127) : 2048 + c;
}
template <int MODE>
__device__ void skinny2d(const SkArgs& a, int b, unsigned char* lds) {
    constexpr int NCB = MODE == SK_UP ? 8 : MODE == SK_RES ? 2 : MODE == SK_GLU ? 4 : 6, NV = MODE == SK_UP ? 8 : 2, K = 1024;
    const int tid = tid_opaque(), w = __builtin_amdgcn_readfirstlane(tid >> 6), lane = tid & 63, fr = lane & 15, fq = lane >> 4;
    const int rb = b & 7, cg = b >> 3, ecb = tid >> 6, erow = 16 * rb + fr;
    const bool red = tid < NV * 64;
    f32x4 basev = (f32x4){0.f, 0.f, 0.f, 0.f}; unsigned long long ssv = 0ull;
    if (red) { if (MODE == SK_RES || MODE == SK_GLU) basev = *(const f32x4*)(a.baseS + (size_t)erow * 1024 + 32 * cg + 16 * ecb + 4 * fq); else ssv = a.ssr[erow]; }
    const bf16_t* ap = a.A + (size_t)erow * K + 128 * w + fq * 8;
    bf16x8 av[4], bv[NCB][4];
#pragma unroll
    for (int u = 0; u < 4; ++u) av[u] = *(const bf16x8*)(ap + u * 32);
#pragma unroll
    for (int cb = 0; cb < NCB; ++cb) { const bf16_t* bp = a.Bt + (size_t)sk2_brow<MODE>(cg, cb, fr) * K + 128 * w + fq * 8;
#pragma unroll
        for (int u = 0; u < 4; ++u) bv[cb][u] = *(const bf16x8*)(bp + u * 32); }
    f32x4* part = (f32x4*)lds;
#pragma unroll
    for (int cb = 0; cb < NCB; ++cb) { f32x4 acc = (f32x4){0.f, 0.f, 0.f, 0.f};
#pragma unroll
        for (int u = 0; u < 4; ++u) acc = __builtin_amdgcn_mfma_f32_16x16x32_bf16(bv[cb][u], av[u], acc, 0, 0, 0);
        part[(w * NCB + cb) * 64 + lane] = acc; }
    __syncthreads();
    if (red) {
        const float SSC = 1.0f / (1024.0f * 1048576.0f);
        f32x4 s0 = part[ecb * 64 + lane];
#pragma unroll
        for (int v = 1; v < 8; ++v) s0 = s0 + part[(v * NCB + ecb) * 64 + lane];
        if (MODE == SK_UP) {
            const float rs2 = __builtin_amdgcn_rcpf((float)ssv * SSC + EPS);
            float h[4];
#pragma unroll
            for (int j = 0; j < 4; ++j) { const float t = fmaxf(s0[j], 0.f); h[j] = t * t * rs2; }
            pg8::u32x2 o; o.x = cvt_pk_bf16(h[0], h[1]); o.y = cvt_pk_bf16(h[2], h[3]);
            *(pg8::u32x2*)(a.O + (size_t)erow * 4096 + 128 * cg + 16 * ecb + 4 * fq) = o;
        } else if (MODE == SK_RES || MODE == SK_GLU) {
            f32x4 val = s0;
            if (MODE == SK_GLU) { f32x4 s1 = part[(2 + ecb) * 64 + lane];
#pragma unroll
                for (int v = 1; v < 8; ++v) s1 = s1 + part[(v * NCB + 2 + ecb) * 64 + lane];
#pragma unroll
                for (int j = 0; j < 4; ++j) val[j] = s0[j] * __builtin_amdgcn_rcpf(1.0f + __expf(-s1[j])); }
            const f32x4 x = val + basev; const size_t o = (size_t)erow * 1024 + 32 * cg + 16 * ecb + 4 * fq;
            *(f32x4*)(a.X + o) = x;
            if (a.XB) { pg8::u32x2 w2; w2.x = cvt_pk_bf16(x[0], x[1]); w2.y = cvt_pk_bf16(x[2], x[3]); *(pg8::u32x2*)(a.XB + o) = w2; }
            float sq = (x[0] * x[0] + x[1] * x[1]) + (x[2] * x[2] + x[3] * x[3]);
            sq += __shfl_xor(sq, 16); sq += __shfl_xor(sq, 32);
            if (fq == 0) atomicAdd(a.ssw + erow, (unsigned long long)(sq * 1048576.0f + 0.5f));
        } else {
            f32x4 s1 = part[(2 + ecb) * 64 + lane], s2 = part[(4 + ecb) * 64 + lane];
#pragma unroll
            for (int v = 1; v < 8; ++v) { s1 = s1 + part[(v * NCB + 2 + ecb) * 64 + lane]; s2 = s2 + part[(v * NCB + 4 + ecb) * 64 + lane]; }
            const float rs2 = __builtin_amdgcn_rcpf((float)ssv * SSC + EPS);
            const size_t o = (size_t)erow * 1024 + 32 * cg + 16 * ecb + 4 * fq;
            const f32x4 cv = s0 * s1 * rs2, bg = s2 * __builtin_sqrtf(rs2);
            pg8::u32x2 w2; w2.x = cvt_pk_bf16(cv[0], cv[1]); w2.y = cvt_pk_bf16(cv[2], cv[3]);
            *(pg8::u32x2*)(a.CV + o) = w2;
            *(f32x4*)(a.convS + ((size_t)erow * 2 + 1) * 1024 + 32 * cg + 16 * ecb + 4 * fq) = cv;
            pg8::u32x2 w3; w3.x = cvt_pk_bf16(bg[0], bg[1]); w3.y = cvt_pk_bf16(bg[2], bg[3]);
            *(pg8::u32x2*)(a.BG + o) = w3;
        }
    }
    __syncthreads();
}
__device__ void skinny_down2d(const SkArgs& a, int b, unsigned char* lds) {
    const int tid = tid_opaque(), w = __builtin_amdgcn_readfirstlane(tid >> 6), lane = tid & 63, fr = lane & 15, fq = lane >> 4;
    constexpr int K = 4096;
    const int rb = b & 7, cg = b >> 3;
    const bf16_t* ap = a.A + (size_t)(16 * rb + fr) * K + 512 * w + fq * 8;
    const bf16_t* bp0 = a.Bt + (size_t)(32 * cg + fr) * K + 512 * w + fq * 8;
    const bf16_t* bp1 = bp0 + (size_t)16 * K;
    const int ecb = tid >> 6, erow = 16 * rb + fr, ecol = 32 * cg + 16 * ecb + 4 * fq;
    f32x4 basev = (f32x4){0.f, 0.f, 0.f, 0.f};
    if (tid < 128) basev = *(const f32x4*)(a.baseS + (size_t)erow * 1024 + ecol);
    f32x4 acc0 = (f32x4){0.f, 0.f, 0.f, 0.f}, acc1 = acc0;
#pragma unroll
    for (int h = 0; h < 2; ++h) {
        bf16x8 av[8], b0[8], b1[8];
#pragma unroll
        for (int u = 0; u < 8; ++u) { av[u] = *(const bf16x8*)(ap + (h * 8 + u) * 32); b0[u] = *(const bf16x8*)(bp0 + (h * 8 + u) * 32); b1[u] = *(const bf16x8*)(bp1 + (h * 8 + u) * 32); }
#pragma unroll
        for (int u = 0; u < 8; ++u) { acc0 = __builtin_amdgcn_mfma_f32_16x16x32_bf16(b0[u], av[u], acc0, 0, 0, 0); acc1 = __builtin_amdgcn_mfma_f32_16x16x32_bf16(b1[u], av[u], acc1, 0, 0, 0); }
    }
    f32x4* part = (f32x4*)lds;
    part[(w * 2 + 0) * 64 + lane] = acc0; part[(w * 2 + 1) * 64 + lane] = acc1;
    __syncthreads();
    if (tid < 128) {
        f32x4 s = part[(0 * 2 + ecb) * 64 + lane];
#pragma unroll
        for (int v = 1; v < 8; ++v) s = s + part[(v * 2 + ecb) * 64 + lane];
        const f32x4 x = s + basev; const size_t o = (size_t)erow * 1024 + ecol;
        *(f32x4*)(a.X + o) = x;
        if (a.XB) { pg8::u32x2 w2; w2.x = cvt_pk_bf16(x[0], x[1]); w2.y = cvt_pk_bf16(x[2], x[3]); *(pg8::u32x2*)(a.XB + o) = w2; }
        float sq = (x[0] * x[0] + x[1] * x[1]) + (x[2] * x[2] + x[3] * x[3]);
        sq += __shfl_xor(sq, 16); sq += __shfl_xor(sq, 32);
        if (fq == 0) atomicAdd(a.ssw + erow, (unsigned long long)(sq * 1048576.0f + 0.5f));
    }
    __syncthreads();
}
__device__ __forceinline__ void unpack8(const u32x4 v, float* f) { f[0] = __uint_as_float(v.x << 16); f[1] = __uint_as_float(v.x & 0xffff0000u); f[2] = __uint_as_float(v.y << 16); f[3] = __uint_as_float(v.y & 0xffff0000u);
    f[4] = __uint_as_float(v.z << 16); f[5] = __uint_as_float(v.z & 0xffff0000u); f[6] = __uint_as_float(v.w << 16); f[7] = __uint_as_float(v.w & 0xffff0000u); }
__device__ void convgate_wg(KP p, int j, int wg) {
    const int tid = tid_opaque(), c = (tid & 127) * 8, strip = tid >> 7;
    const bf16_t* BG = (const bf16_t*)(p->ws + WS_ACT + A_BG); const bf16_t* CV = (const bf16_t*)(p->ws + WS_ACT + A_CV); bf16_t* Z = (bf16_t*)(p->ws + WS_ACT + A_Z);
    const float* cw = p->in[18] + (size_t)j * 3 * D + c;
    float w0[8], w1[8], w2[8];
#pragma unroll
    for (int q = 0; q < 8; ++q) { w0[q] = cw[q]; w1[q] = cw[D + q]; w2[q] = cw[2 * D + q]; }
    const int r0 = wg * 64 + strip * 16;
    float x0[8], x1[8];
    if ((r0 & 2047) != 0) { unpack8(*(const u32x4*)(CV + (size_t)(r0 - 2) * D + c), x0); unpack8(*(const u32x4*)(CV + (size_t)(r0 - 1) * D + c), x1); }
    else {
#pragma unroll
        for (int q = 0; q < 8; ++q) { x0[q] = 0.f; x1[q] = 0.f; } }
    { u32x4 cv[16], bg[16];
#pragma unroll
        for (int i = 0; i < 16; ++i) { const size_t o = (size_t)(r0 + i) * D + c; cv[i] = *(const u32x4*)(CV + o); bg[i] = *(const u32x4*)(BG + o); }
#pragma unroll
        for (int i = 0; i < 16; ++i) { float x2[8], b[8], z[8]; unpack8(cv[i], x2); unpack8(bg[i], b);
#pragma unroll
            for (int q = 0; q < 8; ++q) { z[q] = b[q] * (w0[q] * x0[q] + w1[q] * x1[q] + w2[q] * x2[q]); x0[q] = x1[q]; x1[q] = x2[q]; }
            u32x4 w; w.x = cvt_pk_bf16(z[0], z[1]); w.y = cvt_pk_bf16(z[2], z[3]); w.z = cvt_pk_bf16(z[4], z[5]); w.w = cvt_pk_bf16(z[6], z[7]);
            *(u32x4*)(Z + (size_t)(r0 + i) * D + c) = w; } }
    if (wg < MS && strip == 0) { const int i = wg; const size_t r = (size_t)MP + i;
        const float* sb = p->in[4] + (((size_t)j * MS + i) * 2) * D + c; float* so = p->out + O_CVS + (((size_t)j * MS + i) * 2) * D + c;
        float x2[8], b[8], z[8]; unpack8(*(const u32x4*)(CV + r * D + c), x2); unpack8(*(const u32x4*)(BG + r * D + c), b);
#pragma unroll
        for (int q = 0; q < 8; ++q) { const float s0 = sb[q], s1 = sb[D + q]; so[q] = s1; z[q] = b[q] * (w0[q] * s0 + w1[q] * s1 + w2[q] * x2[q]); }
        u32x4 w; w.x = cvt_pk_bf16(z[0], z[1]); w.y = cvt_pk_bf16(z[2], z[3]); w.z = cvt_pk_bf16(z[4], z[5]); w.w = cvt_pk_bf16(z[6], z[7]);
        *(u32x4*)(Z + r * D + c) = w; }
}
__device__ void final_unit16(KP p, int unit) {
    const int tid = tid_opaque(), c = (tid & 127) * 8;
    const unsigned long long* ss = (const unsigned long long*)(p->ws + WS_SS) + 7 * (size_t)MPAD;
    const float* g = p->in[7] + c; const f32x4 g0 = *(const f32x4*)g, g1 = *(const f32x4*)(g + 4);
    f32x4 v0[4], v1[4]; float rstd[4];
#pragma unroll
    for (int i = 0; i < 4; ++i) { const int r = unit * 16 + i * 4 + (tid >> 7); const float* x = p->out + (size_t)r * D + c; v0[i] = *(const f32x4*)x; v1[i] = *(const f32x4*)(x + 4);
        rstd[i] = rsqrtf((float)ss[r] * (1.0f / (1024.0f * 1048576.0f)) + EPS); }
#pragma unroll
    for (int i = 0; i < 4; ++i) { const int r = unit * 16 + i * 4 + (tid >> 7); float* x = p->out + (size_t)r * D + c;
        *(f32x4*)x = v0[i] * rstd[i] * g0; *(f32x4*)(x + 4) = v1[i] * rstd[i] * g1; }
}

__device__ void decode_final_tail(KP p, int b, unsigned* cnt) {
    const int tid = tid_opaque(), lane = tid & 63, fr = lane & 15, fq = lane >> 4;
    if (tid == 0) { unsigned sp = 0; while (__hip_atomic_load(cnt, __ATOMIC_RELAXED, __HIP_MEMORY_SCOPE_AGENT) < 256u) { __builtin_amdgcn_s_sleep(2); if (++sp > (1u << 22)) break; } }
    __syncthreads();
    if (tid < 128) { const int rb = b & 7, cg = b >> 3, erow = MP + 16 * rb + fr, ecol = 32 * cg + 16 * (tid >> 6) + 4 * fq;
        const unsigned long long* ss = (const unsigned long long*)(p->ws + WS_SS) + 7 * (size_t)MPAD;
        const unsigned long long sv = __hip_atomic_load(ss + erow, __ATOMIC_RELAXED, __HIP_MEMORY_SCOPE_AGENT);
        const float rstd = rsqrtf((float)sv * (1.0f / (1024.0f * 1048576.0f)) + EPS);
        float* x = p->out + (size_t)erow * D + ecol;
        *(f32x4*)x = *(const f32x4*)x * rstd * *(const f32x4*)(p->in[7] + ecol); }
}

__global__ void __launch_bounds__(NTHR) fwd_kernel(Params p_) {
    KP p = (KP)__builtin_amdgcn_kernarg_segment_ptr();
    extern __shared__ __attribute__((aligned(16))) unsigned char lds[];
    cg::grid_group grid = cg::this_grid();
    const int bid = blockIdx.x, G = gridDim.x, tid = threadIdx.x;
    const int ph_lo = p->ph_lo, ph_hi = p->ph_hi;
    volatile LAS unsigned* xst = (volatile LAS unsigned*)((LAS unsigned char*)lds + LDS_TOTAL);
    if (threadIdx.x < 4) xst[threadIdx.x] = 0u;
    __syncthreads();
    XcdBarrier xbar; xbar.bar = (unsigned*)(p->ws + WS_BAR); xbar.x = 0; xbar.st = xst;
    if (ph_hi - ph_lo > 1) xbar = xcd_barrier_post((unsigned*)(p->ws + WS_BAR), xst);
    for (int ph = ph_lo; ph < ph_hi; ++ph) {
        if (ph == 2 || ph == 3 || ph == 12 || ph == 14 || ph == 15 || (ph == 24 && G == 256)) continue;
      {
        asm volatile("" : "+s"(p));
        unsigned char* ws = p->ws;
        unsigned long long* SS = (unsigned long long*)(ws + WS_SS);
        bf16_t* XB = (bf16_t*)(ws + WS_XB);
        const int L = (ph - 1) / 12 * 2;
        const int rel = ph == 0 ? 0 : (ph - 1) % 12 + 1;
        const int jj = L >> 1;
        if (ph == 24) {
            for (int u = (G == 256 ? MP / 16 : 0) + bid; u < MR / 16; u += G) final_unit16(p, u);
        } else if (ph == 0) {
            for (int i = bid * NTHR + tid_opaque(); i < 8 * MPAD; i += G * NTHR) SS[i] = 0ull;
            for (int step = 0; step < 2; ++step) {
              if (((step ^ bid) & 1) == 0) { for (int u = bid; u < NG * 4; u += G) ssm_gen_unit(p, 0, u, lds, (bf16_t*)(ws + WS_ACT + A_WG), (bf16_t*)(ws + WS_ACT + A_TV), ws + WS_PAR); }
              else { for (int u = bid; u < MR / 16; u += G) rowss_unit(p, u, lds); } }
        } else if (rel == 1) {
            const bf16_t* WGm = (jj == 0) ? (const bf16_t*)(ws + WS_ACT + A_WG) : (const bf16_t*)(ws + WS_WG1);
            const bf16_t* TVm = (jj == 0) ? (const bf16_t*)(ws + WS_ACT + A_TV) : (const bf16_t*)(ws + WS_TV1);
            const unsigned char* par = ws + WS_PAR + (size_t)jj * PAR_BYTES;
            const float* srcS = (jj == 0) ? p->in[1] : p->out + (size_t)MP * D;
            const unsigned long long* ssrc = SS + (size_t)(jj == 0 ? 8 : 3) * MPAD;
            const float* gain = p->in[5] + (size_t)(2 * jj) * D;
            for (int step = 0; step < 2; ++step) {
              const bool mix = (ph == 1) ? (((step ^ bid) & 1) == 0) : (step == 0);
              if (mix) {
                for (int u = bid; u < NG * 4; u += G) s5_unit(p, jj, ((u >> 3) & 31) + 32 * ((u >> 2) & 1), 2 * (u & 3), WGm, TVm, par, (const bf16_t*)XB, ssrc, gain, lds);
                for (int u = bid; u < 256; u += G) s5_sample_wg(p, jj, u, par, srcS, ssrc + MP, gain);
              } else if (ph == 1) {
                for (int jb = 0; jb < 14; ++jb) {
                    const float* W; bf16_t* Bt; const float* sc = nullptr; int K, N, mode = 0;
                    if (jb < 2) { W = p->in[16] + (size_t)jb * 1024 * 2048; Bt = (bf16_t*)(ws + W_GLU(jb)); K = 1024; N = 2048; mode = 1; }
                    else if (jb < 6) { const int i = jb - 2; W = p->in[20] + (size_t)i * 1024 * 4096; Bt = (bf16_t*)(ws + W_UP(i)); K = 1024; N = 4096; sc = p->in[6] + (size_t)i * D; }
                    else if (jb < 10) { const int i = jb - 6; W = p->in[21] + (size_t)i * 4096 * 1024; Bt = (bf16_t*)(ws + W_DOWN(i)); K = 4096; N = 1024; }
                    else if (jb < 12) { const int i = jb - 10; W = p->in[17] + (size_t)i * 1024 * 3072; Bt = (bf16_t*)(ws + W_IN(i)); K = 1024; N = 3072; mode = 2; sc = p->in[5] + (size_t)(2 * i + 1) * D; }
                    else { const int i = jb - 12; W = p->in[19] + (size_t)i * 1024 * 1024; Bt = (bf16_t*)(ws + W_OUT(i)); K = 1024; N = 1024; }
                    const int ntiles = (K >> 6) * (N >> 6);
                    const int off = (jb == 1) ? 128 : (jb == 11) ? 192 : (jb == 12) ? 128 : (jb == 13) ? 192 : 0;
                    transpose_job(W, Bt, sc, K, N, mode, (bid + G - off % G) % G, G, ntiles / 4, (float*)lds);
                }
              }
            }
        } else if (rel == 8) {
            for (int step = 0; step < 2; ++step) {
              if (((step ^ bid) & 1) == 0) { for (int u = bid; u < 256; u += G) convgate_wg(p, jj, u); }
              else if (ph == 8) { for (int u = bid; u < NG * 4; u += G) ssm_gen_unit(p, 1, u, lds, (bf16_t*)(ws + WS_WG1), (bf16_t*)(ws + WS_TV1), ws + WS_PAR + PAR_BYTES); } }
        } else {
            pg8::StaticOrder S; pg8::Gemm g;
            PG8_LAS unsigned char* l3 = (PG8_LAS unsigned char*)lds;
            if (rel == 4) {
                g = pg8::Gemm{(const bf16_t*)(ws + WS_ACT + A_YACT), (const bf16_t*)(ws + W_GLU(jj)), MP, 2048, 1024};
                S.init(MP, 2048, G, bid);
                { SkArgs a{}; a.A = g.A + (size_t)MP * 1024; a.Bt = g.Bt; a.K = 1024; a.baseS = (L == 0) ? p->in[1] : p->out + (size_t)MP * D; a.X = p->out + (size_t)MP * D; a.XB = XB + (size_t)MP * D; a.ssw = SS + (size_t)(L * 2) * MPAD + MP;
                  for (int sb = bid; sb < 256; sb += G) skinny2d<SK_GLU>(a, sb, lds); }
                pg8::EpiGlu E{L == 0 ? p->in[0] : p->out, L == 0 ? p->in[1] : p->out + (size_t)MP * D, p->out, XB, SS + (size_t)(L * 2) * MPAD};
                pg8::gemm_phase<pg8::EpiGlu, pg8::StaticOrder, GEMM_ALIGN, GEMM_SP2>(l3, g, S, E);
            } else if (rel == 5 || rel == 10) {
                const int layer = L + (rel == 10), ssi = layer * 2;
                g = pg8::Gemm{XB, (const bf16_t*)(ws + W_UP(layer)), MP, 4096, 1024};
                S.init(MP, 4096, G, bid);
                { SkArgs a{}; a.A = g.A + (size_t)MP * 1024; a.Bt = g.Bt; a.K = 1024; a.O = (bf16_t*)(ws + WS_ACT) + (size_t)MP * 4096; a.ssr = SS + (size_t)ssi * MPAD + MP;
                  for (int sb = bid; sb < 256; sb += G) skinny2d<SK_UP>(a, sb, lds); }
                pg8::EpiUp E{(bf16_t*)(ws + WS_ACT), 4096, SS + (size_t)ssi * MPAD};
                pg8::gemm_phase<pg8::EpiUp, pg8::StaticOrder, GEMM_ALIGN, GEMM_SP2>(l3, g, S, E);
            } else if (rel == 6 || rel == 11 || rel == 9) {
                const int layer = L + (rel != 6);
                const int ssi = (rel == 9) ? layer * 2 : layer * 2 + 1;
                if (rel == 9) { g = pg8::Gemm{(const bf16_t*)(ws + WS_ACT + A_Z), (const bf16_t*)(ws + W_OUT(jj)), MP, 1024, 1024}; }
                else { g = pg8::Gemm{(const bf16_t*)(ws + WS_ACT), (const bf16_t*)(ws + W_DOWN(layer)), MP, 1024, 4096}; }
                S.init(MP, 1024, G, bid);
                { SkArgs a{}; a.A = g.A + (size_t)MP * g.K; a.Bt = g.Bt; a.K = g.K; a.baseS = p->out + (size_t)MP * D; a.X = p->out + (size_t)MP * D; a.XB = (ph == 11) ? nullptr : XB + (size_t)MP * D; a.ssw = SS + (size_t)ssi * MPAD + MP;
                  if (g.K == 1024) { for (int sb = bid; sb < 256; sb += G) skinny2d<SK_RES>(a, sb, lds); } else { for (int sb = bid; sb < 256; sb += G) skinny_down2d(a, sb, lds); }
                  if (ph == 23 && G == 256) {
                      asm volatile("s_waitcnt vmcnt(0)" ::: "memory"); __syncthreads();
                      if (threadIdx.x == 0) __hip_atomic_fetch_add((unsigned*)(ws + WS_CNT) + 32, 1u, __ATOMIC_RELAXED, __HIP_MEMORY_SCOPE_AGENT); } }
                if (ph == 23 && G == 256) { pg8::EpiResFinal EF{p->out, p->out, p->in[7], SS + (size_t)ssi * MPAD, (unsigned*)(ws + WS_CNT)};
                    pg8::gemm_phase<pg8::EpiResFinal, pg8::StaticOrder, false, GEMM_SP2>(l3, g, S, EF);
                    decode_final_tail(p, bid, (unsigned*)(ws + WS_CNT) + 32); } else {
                pg8::EpiRes E{p->out, p->out + (size_t)MP * D, p->out, XB, SS + (size_t)ssi * MPAD, ph == 11 ? 1 : 0};
                pg8::gemm_phase<pg8::EpiRes, pg8::StaticOrder, GEMM_ALIGN, GEMM_SP2>(l3, g, S, E); }
            } else {
                g = pg8::Gemm{XB, (const bf16_t*)(ws + W_IN(jj)), MP, 3072, 1024};
                S.init(MP, 3072, G, bid);
                { SkArgs a{}; a.A = g.A + (size_t)MP * 1024; a.Bt = g.Bt; a.K = 1024; a.ssr = SS + (size_t)(L * 2 + 1) * MPAD + MP; a.BG = (bf16_t*)(ws + WS_ACT + A_BG) + (size_t)MP * D; a.CV = (bf16_t*)(ws + WS_ACT + A_CV) + (size_t)MP * D; a.convS = p->out + O_CVS + (size_t)jj * MS * 2 * D;
                  for (int sb = bid; sb < 256; sb += G) skinny2d<SK_WIN>(a, sb, lds); }
                pg8::EpiWin E{(bf16_t*)(ws + WS_ACT + A_BG), (bf16_t*)(ws + WS_ACT + A_CV), SS + (size_t)(L * 2 + 1) * MPAD, p->out + O_CVP + (size_t)jj * 8 * 2 * D, p->out + O_CVS + (size_t)jj * MS * 2 * D};
                pg8::gemm_phase<pg8::EpiWin, pg8::StaticOrder, GEMM_ALIGN, GEMM_SP2>(l3, g, S, E);
            }
        }
      }
        if (ph_hi > 1000) grid.sync();
        if (ph + 1 < ph_hi && !(ph == 23 && G == 256)) xcd_barrier(xbar);
    }
}

extern "C" void kernel_launch(void* const* d_in, const int* in_sizes, int n_in, void* d_out, int out_size, void* d_ws, size_t ws_size, hipStream_t stream) {
    static int grid = 0;
    if (grid == 0) {
        if (n_in != 22 || ws_size < WS_END) { fprintf(stderr, "kernel_launch: need 22 inputs and %zu bytes of workspace; got %d, %zu\n", (size_t)WS_END, n_in, ws_size); grid = -1; return; }
        int dev = 0, cus = 0, per_cu = 0;
        hipGetDevice(&dev); hipDeviceGetAttribute(&cus, hipDeviceAttributeMultiprocessorCount, dev);
        if (hipFuncSetAttribute((const void*)fwd_kernel, hipFuncAttributeMaxDynamicSharedMemorySize, LDS_TOTAL + 16 + 4096) != hipSuccess) { fprintf(stderr, "kernel_launch: hipFuncSetAttribute failed\n"); grid = -1; return; }
        if (hipOccupancyMaxActiveBlocksPerMultiprocessor(&per_cu, (const void*)fwd_kernel, NTHR, LDS_TOTAL + 16 + 4096) != hipSuccess || per_cu < 1) { fprintf(stderr, "kernel_launch: occupancy query says %d\n", per_cu); (void)hipGetLastError(); per_cu = 1; }
        grid = cus;
    }
    if (grid < 0) return;
    Params p{};
    for (int i = 0; i < 22; ++i) p.in[i] = (const float*)d_in[i];
    p.out = (float*)d_out; p.ws = (unsigned char*)d_ws;
#if defined(MULTI_LAUNCH)
    for (int ph = 0; ph < 25; ++ph) { p.ph_lo = ph; p.ph_hi = ph + 1; hipLaunchKernelGGL(fwd_kernel, dim3(grid), dim3(NTHR), LDS_TOTAL + 16 + 4096, stream, p); }
#else
    p.ph_lo = 0; p.ph_hi = 25;
    if (hipMemsetAsync((char*)d_ws + WS_BAR, 0, 32768, stream) != hipSuccess) { fprintf(stderr, "kernel_launch: memset failed\n"); return; }
    void* args[] = {&p};
    hipError_t e = hipLaunchCooperativeKernel((const void*)fwd_kernel, dim3(grid), dim3(NTHR), args, LDS_TOTAL + 16 + 4096, stream);
    if (e != hipSuccess) fprintf(stderr, "cooperative launch failed: %s (grid %d)\n", hipGetErrorString(e), grid);
#endif
}
```

```cpp
#include <hip/hip_runtime.h>
#include <hip/hip_cooperative_groups.h>
#include <cstdio>
namespace pg8 {
#define PG8_LAS __attribute__((address_space(3)))
typedef unsigned short bf16_t;
typedef short bf16x8 __attribute__((ext_vector_type(8)));
typedef float f32x4 __attribute__((ext_vector_type(4)));
typedef unsigned u32x4 __attribute__((ext_vector_type(4)));
constexpr int BM = 256, BK = 64, HALF = 128, HTB = HALF * BK * 2  , STAGE_BYTES = 8 * HTB, NXCD = 8, WGM = 4;

__host__ __device__ __forceinline__ int lds_byte(int r, int c) { const int st = (r >> 4) * 2 + (c >> 5), rr = r & 15, cc = c & 31, ob = rr * 64 + cc * 2; return st * 1024 + (ob ^ (((ob >> 9) & 1) << 5)); }
__host__ __device__ __forceinline__ void stage_rc(int b, int& R, int& C) { const int st = b / 1024, sb = b % 1024, swz = sb ^ (((sb >> 9) & 1) << 5); R = (st >> 1) * 16 + swz / 64; C = (st & 1) * 32 + (swz % 64) / 2; }
__host__ __device__ __forceinline__ int perm32(int rho) { const int n = rho >> 4, i = rho & 15; return 8 * (i >> 2) + 4 * n + (i & 3); }

struct Unit { int pm, pn; };
struct Gemm { const bf16_t* A; const bf16_t* Bt; int M, N, K; };

struct StaticOrder {
    int nM, nN, nwg, G, c;
    __host__ __device__ void init(int M, int N, int G_, int c_) { nM = M / BM; nN = N / BM; nwg = nM * nN; G = G_; c = c_; }
    __host__ __device__ bool next(int i, Unit& u) const {
        const long L = (long)i * G + c; if (L >= nwg) return false;
        int wgid = (int)L; { const int q = nwg / NXCD, r = nwg % NXCD, xcd = wgid % NXCD, off = wgid / NXCD; wgid = (xcd < r ? xcd * (q + 1) : r * (q + 1) + (xcd - r) * q) + off; }
        const int nig = WGM * nN, gid = wgid / nig, fm = gid * WGM, gsz = (nM - fm) < WGM ? (nM - fm) : WGM;
        u.pm = fm + ((wgid % nig) % gsz); u.pn = (wgid % nig) / gsz; return true;
    }
    __device__ __forceinline__ void a_ready(const Unit&) const {}
    __device__ __forceinline__ void done(const Unit&) const {}
};
struct CountedOrder : StaticOrder {
    const unsigned* ready; unsigned need; unsigned* tmo;
    __device__ __forceinline__ void a_ready(const Unit& u) const {
        if (threadIdx.x < 64) {
            const unsigned long long t0 = __builtin_amdgcn_s_memrealtime(); unsigned polls = 0;
            while ((unsigned)__builtin_amdgcn_readfirstlane(__hip_atomic_load(ready + 64 * u.pm, __ATOMIC_RELAXED, __HIP_MEMORY_SCOPE_AGENT)) < need) {
                if ((++polls & 255u) == 0u && __builtin_amdgcn_readfirstlane(__hip_atomic_load(tmo, __ATOMIC_RELAXED, __HIP_MEMORY_SCOPE_AGENT)) != 0u) break;
                if (__builtin_amdgcn_s_memrealtime() - t0 > 2000000ull) {
                    if (threadIdx.x == 0) { unsigned expect = 0u; __hip_atomic_compare_exchange_strong(tmo + 1, &expect, 0x600u | (unsigned)(u.pm & 0xff), __ATOMIC_RELAXED, __ATOMIC_RELAXED, __HIP_MEMORY_SCOPE_AGENT); __hip_atomic_store(tmo, 1u, __ATOMIC_RELAXED, __HIP_MEMORY_SCOPE_AGENT); }
                    break; }
                __builtin_amdgcn_s_sleep(2); }
            __builtin_amdgcn_fence(__ATOMIC_ACQUIRE, "agent");
            asm volatile("s_waitcnt vmcnt(0)" ::: "memory");
        }
#if !defined(BROKEN_HOOK_NO_BARRIER)
        asm volatile("" ::: "memory"); __builtin_amdgcn_s_barrier(); asm volatile("" ::: "memory");
#endif
    }
};

__device__ __forceinline__ unsigned cvt_pk_bf16(float lo, float hi) { unsigned r; asm volatile("v_cvt_pk_bf16_f32 %0, %1, %2" : "=v"(r) : "v"(lo), "v"(hi)); return r; }
typedef float f32x2 __attribute__((ext_vector_type(2)));
__device__ __forceinline__ f32x2 gelu_pk(f32x2 v) {
    const f32x2 av = __builtin_elementwise_abs(v), d = av * 0.2316418882f + 1.0f;
    f32x2 t; t.x = __builtin_amdgcn_rcpf(d.x); t.y = __builtin_amdgcn_rcpf(d.y);
    f32x2 q = t * 0.5307027145f + (-0.7265760135f); q = q * t + 0.7107068705f; q = q * t + (-0.142248368f); q = q * t + 0.127414796f; q = q * t;
    const f32x2 s = (v * v) * (-0.72134752044f);
    f32x2 e; e.x = __builtin_amdgcn_exp2f(s.x); e.y = __builtin_amdgcn_exp2f(s.y);
    const f32x2 m = v * (q * e), r = v - m;
    f32x2 o; o.x = v.x < 0.f ? m.x : r.x; o.y = v.y < 0.f ? m.y : r.y; return o;
}

constexpr int MPR = 16384, MRR = 16512;
constexpr float RMS_EPS_ = 1e-6f;
typedef unsigned u32x2 __attribute__((ext_vector_type(2)));
__device__ __forceinline__ float sigmoidf_(float z) { return __builtin_amdgcn_rcpf(1.0f + __expf(-z)); }

struct EpiUp {
    static constexpr bool PERM = true, AFTER_DRAIN = false;
    bf16_t* O; int ldc; const unsigned long long* ss;
    __device__ __forceinline__ void operator()(const f32x4 (&acc)[2][2][4][2], const Unit& u, int wr, int wc, int fr, int fq) const {
        const int row0 = u.pm * BM + wr * 64 + fr, col0 = u.pn * BM + wc * 32 + 8 * fq;
        unsigned long long sv[2][4];
#pragma unroll
        for (int ai = 0; ai < 2; ++ai)
#pragma unroll
            for (int m = 0; m < 4; ++m) sv[ai][m] = ss[row0 + ai * HALF + m * 16];
#pragma unroll
        for (int ai = 0; ai < 2; ++ai)
#pragma unroll
            for (int m = 0; m < 4; ++m) { const int r = row0 + ai * HALF + m * 16; const float rs2 = __builtin_amdgcn_rcpf((float)sv[ai][m] * (1.0f / (1024.0f * 1048576.0f)) + RMS_EPS_);
                bf16_t* rowp = O + (size_t)r * ldc + col0;
#pragma unroll
                for (int bj = 0; bj < 2; ++bj) { f32x4 v0 = acc[ai][bj][m][0], v1 = acc[ai][bj][m][1];
#pragma unroll
                    for (int j = 0; j < 4; ++j) { const float a = fmaxf(v0[j], 0.f), b = fmaxf(v1[j], 0.f); v0[j] = a * a * rs2; v1[j] = b * b * rs2; }
                    u32x4 w; w.x = cvt_pk_bf16(v0[0], v0[1]); w.y = cvt_pk_bf16(v0[2], v0[3]); w.z = cvt_pk_bf16(v1[0], v1[1]); w.w = cvt_pk_bf16(v1[2], v1[3]);
                    *(u32x4*)(rowp + bj * HALF) = w; } }
    }
};
struct EpiRes {
    static constexpr bool PERM = true, AFTER_DRAIN = false;
    const float* baseP; const float* baseS; float* X; bf16_t* XB; unsigned long long* ss; int gm;
    __device__ __forceinline__ void operator()(const f32x4 (&acc)[2][2][4][2], const Unit& u, int wr, int wc, int fr, int fq) const {
        const int row0 = u.pm * BM + wr * 64 + fr, col0 = u.pn * BM + wc * 32 + 8 * fq;
#pragma unroll
        for (int ai = 0; ai < 2; ++ai) { if (u.pm * BM + ai * HALF >= MRR) continue;
            f32x4 bv[4][2][2];
#pragma unroll
            for (int m = 0; m < 4; ++m) { const int r = row0 + ai * HALF + m * 16;
                const float* bp = (r < MPR) ? baseP + (size_t)r * 1024 : baseS + (size_t)(r - MPR) * 1024;
#pragma unroll
                for (int bj = 0; bj < 2; ++bj) { bv[m][bj][0] = *(const f32x4*)(bp + col0 + bj * HALF); bv[m][bj][1] = *(const f32x4*)(bp + col0 + bj * HALF + 4); } }
#pragma unroll
            for (int m = 0; m < 4; ++m) { const int r = row0 + ai * HALF + m * 16;
                float sq = 0.f;
#pragma unroll
                for (int bj = 0; bj < 2; ++bj) { const int c = col0 + bj * HALF;
                    const f32x4 v0 = acc[ai][bj][m][0] + bv[m][bj][0], v1 = acc[ai][bj][m][1] + bv[m][bj][1];
                    *(f32x4*)(X + (size_t)r * 1024 + c) = v0; *(f32x4*)(X + (size_t)r * 1024 + c + 4) = v1;
                    u32x4 w; w.x = cvt_pk_bf16(v0[0], v0[1]); w.y = cvt_pk_bf16(v0[2], v0[3]); w.z = cvt_pk_bf16(v1[0], v1[1]); w.w = cvt_pk_bf16(v1[2], v1[3]);
                    if (gm) *(u32x4*)(XB + ((size_t)(c >> 4) * 16640 + r) * 16 + (c & 8)) = w; else *(u32x4*)(XB + (size_t)r * 1024 + c) = w;
                    sq += (v0[0] * v0[0] + v0[1] * v0[1]) + (v0[2] * v0[2] + v0[3] * v0[3]) + (v1[0] * v1[0] + v1[1] * v1[1]) + (v1[2] * v1[2] + v1[3] * v1[3]); }
                sq += __shfl_xor(sq, 16); sq += __shfl_xor(sq, 32);
                if (fq == 0) atomicAdd(ss + r, (unsigned long long)(sq * 1048576.0f + 0.5f)); } }
    }
};
struct EpiResFinal {
    static constexpr bool PERM = true, AFTER_DRAIN = true;
    const float* base; float* out; const float* gain; unsigned long long* ss; unsigned* cnt;
    __device__ __forceinline__ void operator()(const f32x4 (&)[2][2][4][2], const Unit&, int, int, int, int) const {}
    __device__ __forceinline__ void fused(f32x4 (&acc)[2][2][4][2], const Unit& u, int wr, int wc, int fr, int fq, PG8_LAS unsigned char* lds, int wid, int lane) const {
        const int row0 = u.pm * BM + wr * 64 + fr, col0 = u.pn * BM + wc * 32 + 8 * fq;
#pragma unroll
        for (int ai = 0; ai < 2; ++ai) {
            f32x4 bv[4][2][2];
#pragma unroll
            for (int m = 0; m < 4; ++m) { const float* bp = base + (size_t)(row0 + ai * HALF + m * 16) * 1024;
#pragma unroll
                for (int bj = 0; bj < 2; ++bj) { bv[m][bj][0] = *(const f32x4*)(bp + col0 + bj * HALF); bv[m][bj][1] = *(const f32x4*)(bp + col0 + bj * HALF + 4); } }
#pragma unroll
            for (int m = 0; m < 4; ++m) { const int r = row0 + ai * HALF + m * 16; float sq = 0.f;
#pragma unroll
                for (int bj = 0; bj < 2; ++bj) { const f32x4 v0 = acc[ai][bj][m][0] + bv[m][bj][0], v1 = acc[ai][bj][m][1] + bv[m][bj][1]; acc[ai][bj][m][0] = v0; acc[ai][bj][m][1] = v1;
                    sq += (v0[0] * v0[0] + v0[1] * v0[1]) + (v0[2] * v0[2] + v0[3] * v0[3]) + (v1[0] * v1[0] + v1[1] * v1[1]) + (v1[2] * v1[2] + v1[3] * v1[3]); }
                sq += __shfl_xor(sq, 16); sq += __shfl_xor(sq, 32);
                if (fq == 0) atomicAdd(ss + r, (unsigned long long)(sq * 1048576.0f + 0.5f)); } }
        asm volatile("s_waitcnt vmcnt(0)" ::: "memory");
        __builtin_amdgcn_s_barrier();
        if (wid == 0 && lane == 0) {
            __hip_atomic_fetch_add(cnt + 64 * u.pm, 1u, __ATOMIC_RELAXED, __HIP_MEMORY_SCOPE_AGENT);
            unsigned sp = 0;
            while (__hip_atomic_load(cnt + 64 * u.pm, __ATOMIC_RELAXED, __HIP_MEMORY_SCOPE_AGENT) < 4u) { __builtin_amdgcn_s_sleep(2); if (++sp > (1u << 22)) break; }
        }
        asm volatile("s_waitcnt vmcnt(0) lgkmcnt(0)" ::: "memory");
        __builtin_amdgcn_s_barrier();
        asm volatile("" ::: "memory");
        f32x4 g[2][2];
#pragma unroll
        for (int bj = 0; bj < 2; ++bj) { g[bj][0] = *(const f32x4*)(gain + col0 + bj * HALF); g[bj][1] = *(const f32x4*)(gain + col0 + bj * HALF + 4); }
        unsigned long long sv[2][4];
#pragma unroll
        for (int ai = 0; ai < 2; ++ai)
#pragma unroll
            for (int m = 0; m < 4; ++m) sv[ai][m] = __hip_atomic_load(ss + row0 + ai * HALF + m * 16, __ATOMIC_RELAXED, __HIP_MEMORY_SCOPE_AGENT);
#pragma unroll
        for (int ai = 0; ai < 2; ++ai)
#pragma unroll
            for (int m = 0; m < 4; ++m) { const int r = row0 + ai * HALF + m * 16; const float rstd = rsqrtf((float)sv[ai][m] * (1.0f / (1024.0f * 1048576.0f)) + RMS_EPS_);
#pragma unroll
                for (int bj = 0; bj < 2; ++bj) { float* o = out + (size_t)r * 1024 + col0 + bj * HALF;
                    *(f32x4*)o = acc[ai][bj][m][0] * rstd * g[bj][0]; *(f32x4*)(o + 4) = acc[ai][bj][m][1] * rstd * g[bj][1]; } }
    }
};
struct EpiGlu {
    static constexpr bool PERM = true, AFTER_DRAIN = false;
    const float* baseP; const float* baseS; float* X; bf16_t* XB; unsigned long long* ss;
    __device__ __forceinline__ void operator()(const f32x4 (&acc)[2][2][4][2], const Unit& u, int wr, int wc, int fr, int fq) const {
        const int row0 = u.pm * BM + wr * 64 + fr, c = u.pn * HALF + wc * 32 + 8 * fq;
        f32x4 bv[2][4][2];
#pragma unroll
        for (int ai = 0; ai < 2; ++ai)
#pragma unroll
            for (int m = 0; m < 4; ++m) { const int r = row0 + ai * HALF + m * 16;
                const float* bp = (r < MPR) ? baseP + (size_t)r * 1024 : baseS + (size_t)(r - MPR) * 1024;
                bv[ai][m][0] = *(const f32x4*)(bp + c); bv[ai][m][1] = *(const f32x4*)(bp + c + 4); }
#pragma unroll
        for (int ai = 0; ai < 2; ++ai)
#pragma unroll
            for (int m = 0; m < 4; ++m) { const int r = row0 + ai * HALF + m * 16;
                f32x4 v0 = bv[ai][m][0], v1 = bv[ai][m][1];
#pragma unroll
                for (int j = 0; j < 4; ++j) { v0[j] += acc[ai][0][m][0][j] * sigmoidf_(acc[ai][1][m][0][j]); v1[j] += acc[ai][0][m][1][j] * sigmoidf_(acc[ai][1][m][1][j]); }
                *(f32x4*)(X + (size_t)r * 1024 + c) = v0; *(f32x4*)(X + (size_t)r * 1024 + c + 4) = v1;
                u32x4 w; w.x = cvt_pk_bf16(v0[0], v0[1]); w.y = cvt_pk_bf16(v0[2], v0[3]); w.z = cvt_pk_bf16(v1[0], v1[1]); w.w = cvt_pk_bf16(v1[2], v1[3]);
                *(u32x4*)(XB + (size_t)r * 1024 + c) = w;
                float sq = (v0[0] * v0[0] + v0[1] * v0[1]) + (v0[2] * v0[2] + v0[3] * v0[3]) + (v1[0] * v1[0] + v1[1] * v1[1]) + (v1[2] * v1[2] + v1[3] * v1[3]);
                sq += __shfl_xor(sq, 16); sq += __shfl_xor(sq, 32);
                if (fq == 0) atomicAdd(ss + r, (unsigned long long)(sq * 1048576.0f + 0.5f)); }
    }
};
struct EpiWin {
    static constexpr bool PERM = true, AFTER_DRAIN = false;
    bf16_t* BG; bf16_t* CV; const unsigned long long* ss; float* convP; float* convS;
    __device__ __forceinline__ void operator()(const f32x4 (&acc)[2][2][4][2], const Unit& u, int wr, int wc, int fr, int fq) const {
        const int row0 = u.pm * BM + wr * 64 + fr;
        unsigned long long sv[2][4];
#pragma unroll
        for (int ai = 0; ai < 2; ++ai)
#pragma unroll
            for (int m = 0; m < 4; ++m) sv[ai][m] = ss[row0 + ai * HALF + m * 16];
#pragma unroll
        for (int ai = 0; ai < 2; ++ai)
#pragma unroll
            for (int m = 0; m < 4; ++m) { const int r = row0 + ai * HALF + m * 16; const float rs2 = __builtin_amdgcn_rcpf((float)sv[ai][m] * (1.0f / (1024.0f * 1048576.0f)) + RMS_EPS_);
                if (u.pn < 8) { const int c = u.pn * HALF + wc * 32 + 8 * fq;
                    f32x4 v0 = acc[ai][0][m][0] * acc[ai][1][m][0] * rs2, v1 = acc[ai][0][m][1] * acc[ai][1][m][1] * rs2;
                    u32x4 w; w.x = cvt_pk_bf16(v0[0], v0[1]); w.y = cvt_pk_bf16(v0[2], v0[3]); w.z = cvt_pk_bf16(v1[0], v1[1]); w.w = cvt_pk_bf16(v1[2], v1[3]);
                    *(u32x4*)(CV + (size_t)r * 1024 + c) = w;
                    if (r < MPR) { const int t = r & 2047; if (t >= 2046) { float* o = convP + ((size_t)(r >> 11) * 2 + (t - 2046)) * 1024 + c; *(f32x4*)o = v0; *(f32x4*)(o + 4) = v1; } }
                    else if (r < MRR) { float* o = convS + ((size_t)(r - MPR) * 2 + 1) * 1024 + c; *(f32x4*)o = v0; *(f32x4*)(o + 4) = v1; }
                } else { const float rs = __builtin_sqrtf(rs2); const int c = (u.pn - 8) * BM + wc * 32 + 8 * fq;
#pragma unroll
                    for (int bj = 0; bj < 2; ++bj) { const f32x4 v0 = acc[ai][bj][m][0] * rs, v1 = acc[ai][bj][m][1] * rs;
                        u32x4 w; w.x = cvt_pk_bf16(v0[0], v0[1]); w.y = cvt_pk_bf16(v0[2], v0[3]); w.z = cvt_pk_bf16(v1[0], v1[1]); w.w = cvt_pk_bf16(v1[2], v1[3]);
                        *(u32x4*)(BG + (size_t)r * 1024 + c + bj * HALF) = w; } } }
    }
};
template <class Epi, class Sched, bool ALIGN_EPI = false, bool SP2 = false>
__device__ __forceinline__ void gemm_phase(PG8_LAS unsigned char* lds, const Gemm g, const Sched& S, const Epi& E) {
    int tid_ = threadIdx.x; asm volatile("" : "+v"(tid_)); const int tid = tid_, wid = __builtin_amdgcn_readfirstlane(tid >> 6), lane = tid & 63, wr = wid >> 2, wc = wid & 3, fr = lane & 15, fq = lane >> 4;
    const int K = g.K, nt = K / BK;
    unsigned voffA[2], voffB[2];
#pragma unroll
    for (int i = 0; i < 2; ++i) { int R, C; stage_rc(tid * 16 + i * 8192, R, C); const int Rb = Epi::PERM ? ((R & ~31) + perm32(R & 31)) : R;
        voffA[i] = (unsigned)(R * K + C) * 2u; voffB[i] = (unsigned)(Rb * K + C) * 2u; }
    const size_t kstep = (size_t)(BK * 2);
    const size_t hstep = (size_t)HALF * K * 2;
    const size_t tstep = 2 * hstep;
    const unsigned ldsw = (unsigned)wid * 1024u;
    const int aoff = lds_byte(wr * 64 + fr, fq * 8), boff = lds_byte(wc * 32 + fr, fq * 8);
#define PG8_SA(b, h) (((b) * 2 + (h)) * HTB)
#define PG8_SB(b, h) ((4 + (b) * 2 + (h)) * HTB)
#define PG8_STAGE(bufoff, gbase, voff) do { _Pragma("unroll") for (int _i = 0; _i < 2; ++_i) \
        __builtin_amdgcn_global_load_lds((const unsigned*)((const char*)(gbase) + (voff)[_i]), (PG8_LAS unsigned*)(lds + (bufoff) + ldsw + _i * 8192), 16, 0, 0); } while (0)
#define PG8_LDA(dst, b, h) do { _Pragma("unroll") for (int m = 0; m < 4; ++m) _Pragma("unroll") for (int k = 0; k < 2; ++k) dst[m][k] = *(const PG8_LAS bf16x8*)(lds + PG8_SA(b, h) + aoff + m * 2048 + k * 1024); } while (0)
#define PG8_LDB(dst, b, h) do { _Pragma("unroll") for (int n = 0; n < 2; ++n) _Pragma("unroll") for (int k = 0; k < 2; ++k) dst[n][k] = *(const PG8_LAS bf16x8*)(lds + PG8_SB(b, h) + boff + n * 2048 + k * 1024); } while (0)
#define PG8_MMA(ai, bj, At, Bt) do { __builtin_amdgcn_s_setprio(1); _Pragma("unroll") for (int m = 0; m < 4; ++m) _Pragma("unroll") for (int n = 0; n < 2; ++n) _Pragma("unroll") for (int k = 0; k < 2; ++k) \
        acc[ai][bj][m][n] = __builtin_amdgcn_mfma_f32_16x16x32_bf16(Bt[n][k], At[m][k], acc[ai][bj][m][n], 0, 0, 0); __builtin_amdgcn_s_setprio(0); } while (0)
#define PG8_WAIT_V(n) asm volatile("s_waitcnt vmcnt(" #n ")" ::: "memory")
#define PG8_WAIT_L(n) asm volatile("s_waitcnt lgkmcnt(" #n ")" ::: "memory")
#define PG8_BAR __builtin_amdgcn_s_barrier()
#define PG8_SCHED __builtin_amdgcn_sched_barrier(0)
    Unit cur, nxt; int ui = 0;
    if (!S.next(0, cur)) return;
    f32x4 acc[2][2][4][2];
#pragma unroll
    for (int a = 0; a < 2; ++a)
#pragma unroll
        for (int b = 0; b < 2; ++b)
#pragma unroll
            for (int m = 0; m < 4; ++m)
#pragma unroll
                for (int n = 0; n < 2; ++n) acc[a][b][m][n] = (f32x4){0.f, 0.f, 0.f, 0.f};
    bf16x8 At[4][2], B0[2][2], B1[2][2];
    const char* cA = (const char*)g.A + (size_t)cur.pm * tstep; const char* cB = (const char*)g.Bt + (size_t)cur.pn * tstep;
    S.a_ready(cur);
    if constexpr (SP2) {
        PG8_STAGE(PG8_SB(0, 0), cB, voffB); PG8_STAGE(PG8_SB(0, 1), cB + hstep, voffB); PG8_STAGE(PG8_SA(0, 0), cA, voffA); PG8_STAGE(PG8_SA(0, 1), cA + hstep, voffA);
        if (wr == 1) PG8_BAR;
        PG8_WAIT_V(2); PG8_BAR;
        PG8_STAGE(PG8_SB(1, 0), cB + kstep, voffB); PG8_STAGE(PG8_SA(1, 0), cA + kstep, voffA); PG8_STAGE(PG8_SB(1, 1), cB + hstep + kstep, voffB);
        PG8_WAIT_V(6); PG8_BAR;
    } else {
        PG8_STAGE(PG8_SB(0, 0), cB, voffB); PG8_STAGE(PG8_SA(0, 0), cA, voffA); PG8_STAGE(PG8_SB(0, 1), cB + hstep, voffB); PG8_STAGE(PG8_SA(0, 1), cA + hstep, voffA);
        if (wr == 1) PG8_BAR;
        PG8_WAIT_V(4); PG8_BAR;
        PG8_STAGE(PG8_SB(1, 0), cB + kstep, voffB); PG8_STAGE(PG8_SA(1, 0), cA + kstep, voffA); PG8_STAGE(PG8_SB(1, 1), cB + hstep + kstep, voffB);
        PG8_WAIT_V(6); PG8_BAR;
    }
    for (;;) {
        const bool has_next = S.next(ui + 1, nxt);
        const char* nA = has_next ? (const char*)g.A + (size_t)nxt.pm * tstep : cA; const char* nB = has_next ? (const char*)g.Bt + (size_t)nxt.pn * tstep : cB;
        for (int t = 0; t < nt; t += 2) {
            const bool last = (t == nt - 2);
            const char* a1 = cA + (size_t)(t + 1) * kstep;
            const char* a2 = last ? nA : cA + (size_t)(t + 2) * kstep; const char* b2 = last ? nB : cB + (size_t)(t + 2) * kstep;
            const char* a3 = a2 + kstep; const char* b3 = b2 + kstep;
            if (last && has_next) S.a_ready(nxt);
            if constexpr (SP2) {
            PG8_LDB(B0, 0, 0); PG8_LDB(B1, 0, 1); PG8_SCHED; PG8_LDA(At, 0, 0); PG8_STAGE(PG8_SA(1, 1), a1 + hstep, voffA);
            PG8_WAIT_V(8); PG8_WAIT_L(0); PG8_BAR; PG8_MMA(0, 0, At, B0); PG8_MMA(0, 1, At, B1); PG8_BAR; PG8_SCHED;
            PG8_LDA(At, 0, 1); PG8_STAGE(PG8_SB(0, 0), b2, voffB); PG8_STAGE(PG8_SB(0, 1), b2 + hstep, voffB); PG8_STAGE(PG8_SA(0, 0), a2, voffA);
            PG8_WAIT_V(8); PG8_WAIT_L(0); PG8_BAR; PG8_MMA(1, 0, At, B0); PG8_MMA(1, 1, At, B1); PG8_BAR; PG8_SCHED;
            PG8_LDB(B0, 1, 0); PG8_LDB(B1, 1, 1); PG8_SCHED; PG8_LDA(At, 1, 0); PG8_STAGE(PG8_SA(0, 1), a2 + hstep, voffA);
            PG8_WAIT_V(8); PG8_WAIT_L(0); PG8_BAR; PG8_MMA(0, 0, At, B0); PG8_MMA(0, 1, At, B1); PG8_BAR; PG8_SCHED;
            PG8_LDA(At, 1, 1); PG8_STAGE(PG8_SB(1, 0), b3, voffB); PG8_STAGE(PG8_SB(1, 1), b3 + hstep, voffB); PG8_STAGE(PG8_SA(1, 0), a3, voffA);
            PG8_WAIT_V(8); PG8_WAIT_L(0); PG8_BAR; PG8_MMA(1, 0, At, B0); PG8_MMA(1, 1, At, B1); PG8_BAR; PG8_SCHED;
            } else {
            PG8_LDB(B0, 0, 0); PG8_SCHED; PG8_LDA(At, 0, 0); PG8_STAGE(PG8_SA(1, 1), a1 + hstep, voffA);
            PG8_WAIT_L(8); PG8_BAR; PG8_WAIT_L(0); PG8_MMA(0, 0, At, B0); PG8_BAR; PG8_SCHED;
            PG8_LDB(B1, 0, 1); PG8_STAGE(PG8_SB(0, 0), b2, voffB);
            PG8_BAR; PG8_WAIT_L(0); PG8_MMA(0, 1, At, B1); PG8_BAR;
            PG8_LDA(At, 0, 1); PG8_STAGE(PG8_SA(0, 0), a2, voffA);
            PG8_BAR; PG8_WAIT_L(0); PG8_MMA(1, 0, At, B0); PG8_BAR; PG8_SCHED;
            PG8_STAGE(PG8_SB(0, 1), b2 + hstep, voffB);
            PG8_WAIT_V(6); PG8_BAR; PG8_MMA(1, 1, At, B1); PG8_BAR;
            PG8_LDB(B0, 1, 0); PG8_SCHED; PG8_LDA(At, 1, 0); PG8_STAGE(PG8_SA(0, 1), a2 + hstep, voffA);
            PG8_WAIT_L(8); PG8_BAR; PG8_WAIT_L(0); PG8_MMA(0, 0, At, B0); PG8_BAR; PG8_SCHED;
            PG8_LDB(B1, 1, 1); PG8_STAGE(PG8_SB(1, 0), b3, voffB);
            PG8_BAR; PG8_WAIT_L(0); PG8_MMA(0, 1, At, B1); PG8_BAR;
            PG8_LDA(At, 1, 1); PG8_STAGE(PG8_SA(1, 0), a3, voffA);
            PG8_BAR; PG8_WAIT_L(0); PG8_MMA(1, 0, At, B0); PG8_BAR; PG8_SCHED;
            PG8_STAGE(PG8_SB(1, 1), b3 + hstep, voffB);
            PG8_WAIT_V(6); PG8_BAR; PG8_MMA(1, 1, At, B1); PG8_BAR;
            }
        }
        if constexpr (ALIGN_EPI) { if (wr == 0) PG8_BAR; }
        if constexpr (!Epi::AFTER_DRAIN) { E(acc, cur, wr, wc, fr, fq); S.done(cur); }
        if (!has_next) break;
#pragma unroll
        for (int a = 0; a < 2; ++a)
#pragma unroll
            for (int b = 0; b < 2; ++b)
#pragma unroll
                for (int m = 0; m < 4; ++m)
#pragma unroll
                    for (int n = 0; n < 2; ++n) acc[a][b][m][n] = (f32x4){0.f, 0.f, 0.f, 0.f};
        cur = nxt; cA = nA; cB = nB; ++ui;
        if constexpr (ALIGN_EPI) { if (wr == 1) PG8_BAR; }
    }
    PG8_WAIT_V(0);
    if constexpr (!ALIGN_EPI) { if (wr == 0) PG8_BAR; }
    PG8_BAR;
    if constexpr (Epi::AFTER_DRAIN) { E.fused(acc, cur, wr, wc, fr, fq, lds, wid, lane); S.done(cur); }
#undef PG8_SA
#undef PG8_SB
#undef PG8_STAGE
#undef PG8_LDA
#undef PG8_LDB
#undef PG8_MMA
#undef PG8_WAIT_V
#undef PG8_WAIT_L
#undef PG8_BAR
#undef PG8_SCHED
}
}

namespace cg = cooperative_groups;
#ifndef GEMM_SP2
#define GEMM_SP2 true
#endif
#ifndef GEMM_ALIGN
#define GEMM_ALIGN true
#endif
using pg8::bf16_t; using pg8::bf16x8; using pg8::f32x4; using pg8::u32x4; using pg8::cvt_pk_bf16;
typedef float f32x2_t __attribute__((ext_vector_type(2)));

constexpr int D = 1024, FF = 4096, MP = 16384, MS = 128, MR = 16512, MPAD = 16640, NG = 64, NP = 64, NH = 16, RCH = 1024;
constexpr int NTHR = 512;
constexpr float EPS = 1e-6f;

constexpr size_t MiB = 1024 * 1024;
__host__ __device__ constexpr size_t W_GLU(int j) { return j == 0 ? 0 : 20 * MiB; }
__host__ __device__ constexpr size_t W_UP(int i) { return i == 0 ? 4 * MiB : (24 + 8 * (size_t)(i - 1)) * MiB; }
__host__ __device__ constexpr size_t W_DOWN(int i) { return i == 0 ? 12 * MiB : (48 + 8 * (size_t)(i - 1)) * MiB; }
__host__ __device__ constexpr size_t W_IN(int j) { return (72 + 6 * (size_t)j) * MiB; }
__host__ __device__ constexpr size_t W_OUT(int j) { return (84 + 2 * (size_t)j) * MiB; }
constexpr size_t WS_XB = 88 * MiB;
constexpr size_t WS_ACT = WS_XB + (size_t)MPAD * 1024 * 2;
constexpr size_t ACT_BYTES = (size_t)MPAD * 4096 * 2;
constexpr size_t WS_SS = WS_ACT + ACT_BYTES;
constexpr size_t WS_US = WS_SS + 9 * (size_t)MPAD * 8;
constexpr size_t WS_PAR = WS_US + 4096;
constexpr size_t PAR_ABAR = 0, PAR_A16 = 32768, PAR_BB = 65536, PAR_CC = 65536 + 524288, PAR_BYTES = 65536 + 2 * 524288;
constexpr size_t WS_BAR = WS_PAR + 2 * PAR_BYTES;
constexpr size_t WS_CNT = WS_BAR + 16384;
constexpr size_t WS_END = WS_CNT + 16384;
constexpr size_t A_YACT = 0;
constexpr size_t A_WG = 40 * MiB;
constexpr size_t A_TV = 44 * MiB;
constexpr size_t A_BG = 0, A_CV = (size_t)MPAD * 1024 * 2, A_Z = 2 * (size_t)MPAD * 1024 * 2;
constexpr size_t WS_WG1 = 0, WS_TV1 = 4 * MiB;
constexpr int USTR = 528, LDS_S = 128 * USTR, LDS_TOTAL = 2 * 128 * USTR;
static_assert(LDS_TOTAL >= pg8::STAGE_BYTES, "LDS");

constexpr size_t O_Y = 0, O_REP = 16908288, O_IMP = 16973824, O_CVP = 17039360, O_RES = 17072128, O_IMS = 18120704, O_CVS = 19169280;

struct Params {
    const float* in[22];
    float* out; unsigned char* ws;
    int ph_lo, ph_hi;
};
typedef const __attribute__((address_space(4))) Params* KP;


#define XB_TMO      128
#define XB_XCNT(j)  (256  + 64 * (j))
#define XB_XSUB(j)  (1280 + 64 * (j))
#define XB_XGEN(j)  (2304 + 64 * (j))
#define XB_TOP      3328
#define XB_TOPGEN   3392
#define XCD_BAR_WORDS 3456
#define XB_SPIN_CAP (1u << 18)
#define LAS __attribute__((address_space(3)))
__device__ __forceinline__ unsigned xb_ld(unsigned* p)              { return __hip_atomic_load(p, __ATOMIC_RELAXED, __HIP_MEMORY_SCOPE_AGENT); }
__device__ __forceinline__ unsigned xb_add(unsigned* p, unsigned v) { return __hip_atomic_fetch_add(p, v, __ATOMIC_RELAXED, __HIP_MEMORY_SCOPE_AGENT); }
__device__ __forceinline__ unsigned xb_xcc_id() { return (unsigned)__builtin_amdgcn_s_getreg((3 << 11) | 20) & 0xFu; }
#define XB_SPIN(cond, bar) do { unsigned _sp = 0; while (cond) { __builtin_amdgcn_s_sleep(1); \
    if ((++_sp & 255u) == 0u) { if (xb_ld(&(bar)[XB_TMO])) break; if (_sp > XB_SPIN_CAP) { atomicAdd(&(bar)[XB_TMO], 1u); break; } } } } while (0)
struct XcdBarrier { unsigned* bar; unsigned x; volatile LAS unsigned* st; };
__device__ __forceinline__ XcdBarrier xcd_barrier_post(unsigned* bar, volatile LAS unsigned* st) {
    XcdBarrier b; b.bar = bar; b.x = xb_xcc_id(); b.st = st;
    if (threadIdx.x == 0) (void)xb_add(&bar[XB_XCNT(b.x)], 1u);
    return b;
}
__device__ __forceinline__ void xcd_barrier_complete(unsigned* bar, unsigned x, unsigned& nloc, unsigned& nx) {
    const unsigned G = gridDim.x * gridDim.y * gridDim.z;
    unsigned sum, cnt, mine, sp = 0u;
    for (;;) {
        sum = 0u; cnt = 0u; mine = 0u;
#pragma unroll
        for (unsigned j = 0; j < 16; ++j) { const unsigned c = xb_ld(&bar[XB_XCNT(j)]); sum += c; cnt += (c > 0u) ? 1u : 0u; mine = (j == x) ? c : mine; }
        if (sum == G) break;
        __builtin_amdgcn_s_sleep(1);
        if ((++sp & 255u) == 0u) { if (xb_ld(&bar[XB_TMO])) break; if (sp > XB_SPIN_CAP) { atomicAdd(&bar[XB_TMO], 1u); break; } }
    }
    nloc = mine > 0u ? mine : 1u; nx = cnt > 0u ? cnt : 1u;
}
__device__ __forceinline__ void xcd_barrier(const XcdBarrier& b) {
    asm volatile("s_waitcnt vmcnt(0)" ::: "memory");
    __syncthreads();
    if (threadIdx.x == 0) {
        unsigned* bar = b.bar;
        __builtin_amdgcn_s_waitcnt(0);
        unsigned nloc = b.st[0], nx = b.st[1];
        if (nloc == 0u) { xcd_barrier_complete(bar, b.x, nloc, nx); b.st[0] = nloc; b.st[1] = nx; }
        const unsigned old = xb_add(&bar[XB_XSUB(b.x)], 1u);
        const unsigned gen = old / nloc;
        if (old + 1u == (gen + 1u) * nloc) {
            __builtin_amdgcn_fence(__ATOMIC_RELEASE, "agent");
            asm volatile("s_waitcnt vmcnt(0)" ::: "memory");
            const unsigned og = xb_add(&bar[XB_TOP], 1u);
            const unsigned tg = og / nx;
            if (og + 1u == (tg + 1u) * nx) xb_add(&bar[XB_TOPGEN], 1u);
            else XB_SPIN(xb_ld(&bar[XB_TOPGEN]) == tg, bar);
            __builtin_amdgcn_fence(__ATOMIC_ACQUIRE, "agent");
            xb_add(&bar[XB_XGEN(b.x)], 1u);
            asm volatile("s_waitcnt vmcnt(0)" ::: "memory");
        } else {
            XB_SPIN(xb_ld(&bar[XB_XGEN(b.x)]) == gen, bar);
            __builtin_amdgcn_fence(__ATOMIC_ACQUIRE, "agent");
            asm volatile("s_waitcnt vmcnt(0)" ::: "memory");
        }
    }
    __syncthreads();
}

__device__ __forceinline__ int tid_opaque() { int t = threadIdx.x; asm volatile("" : "+v"(t)); return t; }
__device__ __forceinline__ float wave_sum(float v) {
#pragma unroll
    for (int o = 32; o >= 1; o >>= 1) v += __shfl_xor(v, o);
    return v;
}
__device__ __forceinline__ float gelu_tanh(float x) {
    const float z = 1.5957691216f * (x + 0.044715f * x * x * x);
    return x * __builtin_amdgcn_rcpf(1.0f + __expf(-z));
}

__device__ __forceinline__ int src_col(int mode, int np) {
    if (mode == 1) { const int pn = np >> 8, h = (np >> 7) & 1, i = np & 127; return h * 1024 + pn * 128 + i; }
    if (mode == 2) { const int pn = np >> 8; if (pn < 8) { const int h = (np >> 7) & 1, i = np & 127; return (1 + h) * 1024 + pn * 128 + i; } return np - 2048; }
    return np;
}
__device__ void transpose_job(const float* __restrict__ W, bf16_t* __restrict__ Bt, const float* __restrict__ scale, int K, int N, int mode, int first, int stride, int nunits, float* tl  ) {
    const int tid = tid_opaque(), nkt = K >> 6;
    const int kk0 = tid >> 4, n4 = (tid & 15) * 4;
    f32x4 v[4][2], vn[4][2];
    auto issue = [&](int unit, f32x4 (&d)[4][2]) {
#pragma unroll
        for (int q = 0; q < 4; ++q) { const int tile = unit * 4 + q, nt = tile / nkt, kt = tile - nt * nkt, k0 = kt << 6, n0 = src_col(mode, nt << 6);
#pragma unroll
            for (int it = 0; it < 2; ++it) d[q][it] = *(const f32x4*)(W + (size_t)(k0 + it * 32 + kk0) * N + n0 + n4); } };
    if (first < nunits) issue(first, v);
    for (int unit = first; unit < nunits; unit += stride) {
        const bool more = unit + stride < nunits;
        if (more) issue(unit + stride, vn);
#pragma unroll
        for (int q = 0; q < 4; ++q) { const int tile = unit * 4 + q, nt = tile / nkt, kt = tile - nt * nkt, k0 = kt << 6;
#pragma unroll
            for (int it = 0; it < 2; ++it) { const int kk = it * 32 + kk0; f32x4 x = v[q][it]; if (scale) x = x * scale[k0 + kk];
                float* t = tl + q * 4160 + kk * 65 + n4; t[0] = x[0]; t[1] = x[1]; t[2] = x[2]; t[3] = x[3]; } }
        __syncthreads();
#pragma unroll
        for (int q = 0; q < 4; ++q) { const int tile = unit * 4 + q, nt = tile / nkt, kt = tile - nt * nkt, k0 = kt << 6, np0 = nt << 6;
            const int n = tid >> 3, k8 = (tid & 7) * 8; float f[8];
#pragma unroll
            for (int j = 0; j < 8; ++j) f[j] = tl[q * 4160 + (k8 + j) * 65 + n];
            u32x4 w; w.x = cvt_pk_bf16(f[0], f[1]); w.y = cvt_pk_bf16(f[2], f[3]); w.z = cvt_pk_bf16(f[4], f[5]); w.w = cvt_pk_bf16(f[6], f[7]);
            *(u32x4*)(Bt + (size_t)(np0 + n) * K + k0 + k8) = w; }
        __syncthreads();
        if (more) {
#pragma unroll
            for (int q = 0; q < 4; ++q) { v[q][0] = vn[q][0]; v[q][1] = vn[q][1]; } }
    }
}

__device__ void ssm_gen_unit(KP p, int j, int part, unsigned char* lds, bf16_t* WGm, bf16_t* TVm, unsigned char* par) {
    f32x2_t* apow = (f32x2_t*)lds;
    f32x2_t* Bb = apow + 17 * 64;
    f32x2_t* Cc = Bb + 1024;
    float* Kt = (float*)(Cc + 1024);
    f32x2_t* qf = (f32x2_t*)(Kt + 4096);
    const int tid = tid_opaque(), g = part >> 2, q = part & 3;
    const float* a_re = p->in[8] + (size_t)(j * NG + g) * NP; const float* a_im = p->in[9] + (size_t)(j * NG + g) * NP;
    const float dt = expf(p->in[10][j * NG + g]);
    for (int idx = tid; idx < 17 * 64 + 64; idx += NTHR) {
        if (idx < 17 * 64) { const int tau = idx >> 6, pp = idx & 63; const float x = (float)tau * dt * a_re[pp], y = (float)tau * dt * a_im[pp]; float s, c; sincosf(y, &s, &c); const float e = expf(x);
            const f32x2_t v = (f32x2_t){e * c, e * s}; apow[idx] = v;
            if (q == 0 && tau == 1) ((f32x2_t*)(par + PAR_ABAR))[g * 64 + pp] = v;
            if (q == 0 && tau == 16) ((f32x2_t*)(par + PAR_A16))[g * 64 + pp] = v; }
        else { const int pp = idx - 17 * 64; const float ar = a_re[pp], ai = a_im[pp]; const float x = dt * ar, y = dt * ai; float s, c, sh, ch; sincosf(y, &s, &c); sincosf(0.5f * y, &sh, &ch);
            const float er = expm1f(x) * c - 2.0f * sh * sh, ei = expf(x) * s;
            const float den = 1.0f / (ar * ar + ai * ai); qf[pp] = (f32x2_t){(er * ar + ei * ai) * den, (ei * ar - er * ai) * den}; } }
    for (int i = tid; i < 1024; i += NTHR) { const size_t ci = (size_t)(j * NG + g) * 1024 + i; const f32x2_t cc = (f32x2_t){p->in[13][ci], p->in[14][ci]};
        Cc[i] = cc; if (q == 0) ((f32x2_t*)(par + PAR_CC))[(size_t)g * 1024 + i] = cc; }
    __syncthreads();
    for (int i = tid; i < 1024; i += NTHR) { const int pp = i >> 4, h = i & 15; const f32x2_t qq = qf[pp];
        const size_t bi = ((size_t)(j * NG + g) * NP + pp) * NH + h; const float br = p->in[11][bi], bim = p->in[12][bi];
        const f32x2_t bb = (f32x2_t){qq.x * br - qq.y * bim, qq.x * bim + qq.y * br};
        Bb[pp * 16 + h] = bb; if (q == 0) ((f32x2_t*)(par + PAR_BB))[((size_t)g * NH + h) * NP + pp] = bb; }
    __syncthreads();
    for (int i2 = tid; i2 < 1024; i2 += NTHR) { const int tau = i2 >> 6, ho = 4 * q + ((i2 >> 4) & 3), hi = i2 & 15; float acc = 0.f;
        for (int pp = 0; pp < 64; ++pp) { const f32x2_t c = Cc[ho * 64 + pp], a = apow[tau * 64 + pp], b = Bb[pp * 16 + hi];
            const float car = c.x * a.x - c.y * a.y, cai = c.x * a.y + c.y * a.x; acc += car * b.x - cai * b.y; }
        if (tau == 0 && ho == hi) acc += p->in[15][j * D + g * 16 + ho];
        Kt[(tau * 16 + ho) * 16 + hi] = acc; }
    __syncthreads();
    bf16_t* TV = TVm + (size_t)g * 256 * 384;
    for (int it = tid; it < 1024; it += NTHR) { const int s = it & 15, ho = 4 * q + ((it >> 4) & 3), t = it >> 6, n = t * 16 + ho; float f[16];
#pragma unroll
        for (int hi = 0; hi < 16; ++hi) f[hi] = (s <= t) ? Kt[((t - s) * 16 + ho) * 16 + hi] : 0.f;
        u32x4 w0, w1; w0.x = cvt_pk_bf16(f[0], f[1]); w0.y = cvt_pk_bf16(f[2], f[3]); w0.z = cvt_pk_bf16(f[4], f[5]); w0.w = cvt_pk_bf16(f[6], f[7]);
        w1.x = cvt_pk_bf16(f[8], f[9]); w1.y = cvt_pk_bf16(f[10], f[11]); w1.z = cvt_pk_bf16(f[12], f[13]); w1.w = cvt_pk_bf16(f[14], f[15]);
        u32x4* o = (u32x4*)(TV + (size_t)n * 384 + s * 16); o[0] = w0; o[1] = w1; }
    for (int it = tid; it < 1024; it += NTHR) { const int p4 = (it & 15) * 4, ho = 4 * q + ((it >> 4) & 3), t = it >> 6, n = t * 16 + ho; float f[8];
#pragma unroll
        for (int r = 0; r < 4; ++r) { const f32x2_t c = Cc[ho * 64 + p4 + r], a = apow[(t + 1) * 64 + p4 + r]; f[2 * r] = c.x * a.x - c.y * a.y; f[2 * r + 1] = -(c.x * a.y + c.y * a.x); }
        u32x4 w; w.x = cvt_pk_bf16(f[0], f[1]); w.y = cvt_pk_bf16(f[2], f[3]); w.z = cvt_pk_bf16(f[4], f[5]); w.w = cvt_pk_bf16(f[6], f[7]);
        *(u32x4*)(TV + (size_t)n * 384 + 256 + 2 * p4) = w; }
    bf16_t* WG = WGm + (size_t)g * 128 * 256;
    { const int n = 32 * q + (tid >> 4), s = tid & 15, pp = n >> 1, c = n & 1; const f32x2_t a = apow[(15 - s) * 64 + pp]; float f[16];
#pragma unroll
        for (int hi = 0; hi < 16; ++hi) { const f32x2_t b = Bb[pp * 16 + hi]; f[hi] = c ? (a.x * b.y + a.y * b.x) : (a.x * b.x - a.y * b.y); }
        u32x4 w0, w1; w0.x = cvt_pk_bf16(f[0], f[1]); w0.y = cvt_pk_bf16(f[2], f[3]); w0.z = cvt_pk_bf16(f[4], f[5]); w0.w = cvt_pk_bf16(f[6], f[7]);
        w1.x = cvt_pk_bf16(f[8], f[9]); w1.y = cvt_pk_bf16(f[10], f[11]); w1.z = cvt_pk_bf16(f[12], f[13]); w1.w = cvt_pk_bf16(f[14], f[15]);
        u32x4* o = (u32x4*)(WG + (size_t)n * 256 + s * 16); o[0] = w0; o[1] = w1; }
    __syncthreads();
}

__device__ void rowss_unit(KP p, int unit, unsigned char* lds) {
    const int tid = tid_opaque(), w = tid >> 6, lane = tid & 63;
    unsigned long long* ss = (unsigned long long*)(p->ws + WS_SS) + 8 * (size_t)MPAD;
    bf16_t* tile = (bf16_t*)lds;
    f32x4 v[2][4];
#pragma unroll
    for (int tt = 0; tt < 2; ++tt) { const int r = unit * 16 + w * 2 + tt; const float* row = (r < MP) ? p->in[0] + (size_t)r * D : p->in[1] + (size_t)(r - MP) * D;
#pragma unroll
        for (int q = 0; q < 4; ++q) v[tt][q] = *(const f32x4*)(row + lane * 16 + q * 4); }
#pragma unroll
    for (int tt = 0; tt < 2; ++tt) { float sq = 0.f;
#pragma unroll
        for (int q = 0; q < 4; ++q) sq += (v[tt][q][0] * v[tt][q][0] + v[tt][q][1] * v[tt][q][1]) + (v[tt][q][2] * v[tt][q][2] + v[tt][q][3] * v[tt][q][3]);
        sq = wave_sum(sq);
        if (lane == 0) ss[unit * 16 + w * 2 + tt] = (unsigned long long)(sq * 1048576.0f + 0.5f);
        u32x4 w0, w1; w0.x = cvt_pk_bf16(v[tt][0][0], v[tt][0][1]); w0.y = cvt_pk_bf16(v[tt][0][2], v[tt][0][3]); w0.z = cvt_pk_bf16(v[tt][1][0], v[tt][1][1]); w0.w = cvt_pk_bf16(v[tt][1][2], v[tt][1][3]);
        w1.x = cvt_pk_bf16(v[tt][2][0], v[tt][2][1]); w1.y = cvt_pk_bf16(v[tt][2][2], v[tt][2][3]); w1.z = cvt_pk_bf16(v[tt][3][0], v[tt][3][1]); w1.w = cvt_pk_bf16(v[tt][3][2], v[tt][3][3]);
        u32x4* o = (u32x4*)(tile + (w * 2 + tt) * 1024 + lane * 16); o[0] = w0; o[1] = w1; }
    if (unit * 16 < MP) {
        __syncthreads();
        bf16_t* XG = (bf16_t*)(p->ws + WS_XB);
#pragma unroll
        for (int i = 0; i < 4; ++i) { const int idx = i * NTHR + tid, g = idx >> 5, q = idx & 31, t = q >> 1, half = q & 1;
            const u32x4 x = *(const u32x4*)(tile + t * 1024 + g * 16 + half * 8);
            *(u32x4*)(XG + ((size_t)g * MPAD + unit * 16) * 16 + q * 8) = x; }
        __syncthreads(); }
}

__device__ void s5_unit(KP p, int j, int g, int b0, const bf16_t* WGm, const bf16_t* TVm, const unsigned char* par, const bf16_t* XG, const unsigned long long* ssrc, const float* gain, unsigned char* lds) {
    const int tid = tid_opaque(), w = __builtin_amdgcn_readfirstlane(tid >> 6), lane = tid & 63, fr = lane & 15, fq = lane >> 4;
    const bf16_t* WG = WGm + (size_t)g * 128 * 256; const bf16_t* TV = TVm + (size_t)g * 256 * 384;
    const float SSC = 1.0f / (1024.0f * 1048576.0f);
    const int t0 = w, t1 = 15 - w, kmax0 = t0 >> 1, kmax1 = t1 >> 1;
    bf16x8 tf0[12], tf1[12];
#pragma unroll
    for (int ks = 0; ks < 12; ++ks) { tf0[ks] = *(const bf16x8*)(TV + (size_t)(t0 * 16 + fr) * 384 + ks * 32 + fq * 8); tf1[ks] = *(const bf16x8*)(TV + (size_t)(t1 * 16 + fr) * 384 + ks * 32 + fq * 8); }
  for (int b = b0; b < b0 + 2; ++b) {
    float* rt = (float*)(lds + LDS_S);
#pragma unroll
    for (int i = 0; i < 4; ++i) { const int tok = i * NTHR + tid; rt[tok] = rsqrtf((float)ssrc[b * 2048 + tok] * SSC + EPS); }
    u32x4 xv[8];
    { const bf16_t* xs = XG + ((size_t)g * MPAD + (size_t)b * 2048) * 16;
#pragma unroll
      for (int i = 0; i < 8; ++i) xv[i] = *(const u32x4*)(xs + (size_t)(i * NTHR + tid) * 8); }
    const f32x4 gv0 = *(const f32x4*)(gain + g * 16 + (tid & 1) * 8), gv1 = *(const f32x4*)(gain + g * 16 + (tid & 1) * 8 + 4);
    __syncthreads();
#pragma unroll
    for (int i = 0; i < 8; ++i) { const int idx = i * NTHR + tid, tok = idx >> 1, half = idx & 1; const float r = rt[tok]; const u32x4 x = xv[i];
        f32x4 a, c; a[0] = __uint_as_float(x.x << 16); a[1] = __uint_as_float(x.x & 0xffff0000u); a[2] = __uint_as_float(x.y << 16); a[3] = __uint_as_float(x.y & 0xffff0000u);
        c[0] = __uint_as_float(x.z << 16); c[1] = __uint_as_float(x.z & 0xffff0000u); c[2] = __uint_as_float(x.w << 16); c[3] = __uint_as_float(x.w & 0xffff0000u);
        a = a * r * gv0; c = c * r * gv1;
        u32x4 o; o.x = cvt_pk_bf16(a[0], a[1]); o.y = cvt_pk_bf16(a[2], a[3]); o.z = cvt_pk_bf16(c[0], c[1]); o.w = cvt_pk_bf16(c[2], c[3]);
        *(u32x4*)(lds + (tok >> 4) * USTR + ((tok & 15) * 16 + half * 8) * 2) = o; }
    bf16x8 wfr[8];
#pragma unroll
    for (int ks = 0; ks < 8; ++ks) wfr[ks] = *(const bf16x8*)(WG + (size_t)(w * 16 + fr) * 256 + ks * 32 + fq * 8);
    __syncthreads();
#pragma unroll 1
    for (int rb = 0; rb < 8; ++rb) { const unsigned char* arow = lds + (rb * 16 + fr) * USTR + fq * 16;
        f32x4 acc = (f32x4){0.f, 0.f, 0.f, 0.f};
#pragma unroll
        for (int ks = 0; ks < 8; ++ks) acc = __builtin_amdgcn_mfma_f32_16x16x32_bf16(wfr[ks], *(const bf16x8*)(arow + ks * 64), acc, 0, 0, 0);
        *(f32x4*)(lds + LDS_S + (rb * 16 + fr) * USTR + (16 * w + 4 * fq) * 4) = acc; }
    __syncthreads();
    {
        const f32x2_t a16 = ((const f32x2_t*)(par + PAR_A16))[g * 64 + lane];
        f32x2_t* tot = (f32x2_t*)(lds + LDS_TOTAL + 16);
        f32x2_t sv[16];
#pragma unroll
        for (int i = 0; i < 16; ++i) sv[i] = *(const f32x2_t*)(lds + LDS_S + (16 * w + i) * USTR + lane * 8);
        float lr = 0.f, li = 0.f, er[16], ei[16];
#pragma unroll
        for (int i = 0; i < 16; ++i) { er[i] = lr; ei[i] = li; const float nr = a16.x * lr - a16.y * li + sv[i].x, ni = a16.x * li + a16.y * lr + sv[i].y; lr = nr; li = ni; }
        tot[w * 64 + lane] = (f32x2_t){lr, li};
        float qr = a16.x, qi = a16.y;
#pragma unroll
        for (int t = 0; t < 4; ++t) { const float nr = qr * qr - qi * qi, ni = 2.0f * qr * qi; qr = nr; qi = ni; }
        __syncthreads();
        float gr = 0.f, gi = 0.f;
        for (int v = 0; v < w; ++v) { const f32x2_t tv = tot[v * 64 + lane]; const float nr = qr * gr - qi * gi + tv.x, ni = qr * gi + qi * gr + tv.y; gr = nr; gi = ni; }
        float pr = 1.f, pi = 0.f;
#pragma unroll
        for (int i = 0; i < 16; ++i) { const float hr = pr * gr - pi * gi + er[i], hi = pr * gi + pi * gr + ei[i];
            *(unsigned*)(lds + LDS_S + (16 * w + i) * USTR + lane * 4) = cvt_pk_bf16(hr, hi);
            const float nr = pr * a16.x - pi * a16.y, ni = pr * a16.y + pi * a16.x; pr = nr; pi = ni; }
        if (w == 7) { const float hr = pr * gr - pi * gi + lr, hi = pr * gi + pi * gr + li;
            const size_t oi = (((size_t)j * 8 + b) * NG + g) * NP + lane;
            p->out[O_REP + oi] = hr; p->out[O_IMP + oi] = hi; }
    }
    __syncthreads();
    bf16_t* Y = (bf16_t*)(p->ws + WS_ACT + A_YACT);
#pragma unroll 1
    for (int rb = 0; rb < 8; ++rb) { const int c = rb * 16 + fr; const unsigned char* arow = lds + c * USTR + fq * 16; const unsigned char* hrow = lds + LDS_S + c * USTR + fq * 16;
        f32x4 acc0 = (f32x4){0.f, 0.f, 0.f, 0.f}, acc1 = acc0;
#pragma unroll
        for (int ks = 0; ks < 8; ++ks) { if (ks <= kmax1) { const bf16x8 a = *(const bf16x8*)(arow + ks * 64);
                acc1 = __builtin_amdgcn_mfma_f32_16x16x32_bf16(tf1[ks], a, acc1, 0, 0, 0);
                if (ks <= kmax0) acc0 = __builtin_amdgcn_mfma_f32_16x16x32_bf16(tf0[ks], a, acc0, 0, 0, 0); } }
#pragma unroll
        for (int ks = 0; ks < 4; ++ks) { const bf16x8 a = *(const bf16x8*)(hrow + ks * 64);
            acc0 = __builtin_amdgcn_mfma_f32_16x16x32_bf16(tf0[8 + ks], a, acc0, 0, 0, 0); acc1 = __builtin_amdgcn_mfma_f32_16x16x32_bf16(tf1[8 + ks], a, acc1, 0, 0, 0); }
        pg8::u32x2 w0, w1; w0.x = cvt_pk_bf16(gelu_tanh(acc0[0]), gelu_tanh(acc0[1])); w0.y = cvt_pk_bf16(gelu_tanh(acc0[2]), gelu_tanh(acc0[3]));
        w1.x = cvt_pk_bf16(gelu_tanh(acc1[0]), gelu_tanh(acc1[1])); w1.y = cvt_pk_bf16(gelu_tanh(acc1[2]), gelu_tanh(acc1[3]));
        const size_t tokb = (size_t)b * 2048 + (size_t)c * 16;
        *(pg8::u32x2*)(Y + (tokb + t0) * D + g * 16 + fq * 4) = w0;
        *(pg8::u32x2*)(Y + (tokb + t1) * D + g * 16 + fq * 4) = w1; }
    __syncthreads();
  }
}
__device__ void s5_sample_wg(KP p, int j, int wgu, const unsigned char* par, const float* srcS, const unsigned long long* ssrcS, const float* gain) {
    const int tid = tid_opaque(), w = tid >> 6, lane = tid & 63, i0 = wgu >> 3, g = (wgu & 7) * 8 + w;
    f32x4 uq[4][4]; unsigned long long ssv[4]; float h0r[4], h0i[4];
#pragma unroll
    for (int s = 0; s < 4; ++s) { const int i = i0 + 32 * s; const float* u = srcS + (size_t)i * D + g * 16;
#pragma unroll
        for (int q = 0; q < 4; ++q) uq[s][q] = *(const f32x4*)(u + q * 4);
        ssv[s] = ssrcS[i]; const size_t si = (((size_t)j * MS + i) * NG + g) * NP + lane; h0r[s] = p->in[2][si]; h0i[s] = p->in[3][si]; }
    f32x4 gq[4];
#pragma unroll
    for (int q = 0; q < 4; ++q) gq[q] = *(const f32x4*)(gain + g * 16 + q * 4);
    const f32x2_t a = ((const f32x2_t*)(par + PAR_ABAR))[g * 64 + lane];
    f32x2_t Bb[16], Cc[16];
#pragma unroll
    for (int h = 0; h < 16; ++h) { Bb[h] = ((const f32x2_t*)(par + PAR_BB))[((size_t)g * NH + h) * NP + lane]; Cc[h] = ((const f32x2_t*)(par + PAR_CC))[(size_t)g * 1024 + h * 64 + lane]; }
    const float d = (lane < 16) ? p->in[15][j * D + g * 16 + lane] : 0.f;
#pragma unroll
    for (int s = 0; s < 4; ++s) { const int i = i0 + 32 * s;
        const float rstd = rsqrtf((float)ssv[s] * (1.0f / (1024.0f * 1048576.0f)) + EPS);
        float uv[16];
#pragma unroll
        for (int q = 0; q < 4; ++q) { const f32x4 t = uq[s][q] * rstd * gq[q]; uv[4 * q] = t[0]; uv[4 * q + 1] = t[1]; uv[4 * q + 2] = t[2]; uv[4 * q + 3] = t[3]; }
        float hr = a.x * h0r[s] - a.y * h0i[s], hi = a.x * h0i[s] + a.y * h0r[s];
#pragma unroll
        for (int h = 0; h < 16; ++h) { hr += Bb[h].x * uv[h]; hi += Bb[h].y * uv[h]; }
        const size_t si = (((size_t)j * MS + i) * NG + g) * NP + lane;
        p->out[O_RES + si] = hr; p->out[O_IMS + si] = hi;
        float y = 0.f;
#pragma unroll
        for (int ho = 0; ho < 16; ++ho) { const float sm = wave_sum(Cc[ho].x * hr - Cc[ho].y * hi); if (lane == ho) y = sm; }
        if (lane < 16) { float ul = 0.f;
#pragma unroll
            for (int h = 0; h < 16; ++h) ul = (lane == h) ? uv[h] : ul;
            const float v = gelu_tanh(y + d * ul);
            bf16_t* Y = (bf16_t*)(p->ws + WS_ACT + A_YACT) + (size_t)(MP + i) * D + g * 16 + lane;
            *Y = (bf16_t)(cvt_pk_bf16(v, 0.f) & 0xffffu); } }
}

enum { SK_UP = 0, SK_RES = 1, SK_GLU = 2, SK_WIN = 3 };
struct SkArgs { const bf16_t* A; const bf16_t* Bt; int K;
    bf16_t* O;
    const float* baseS; float* X; bf16_t* XB; unsigned long long* ssw;
    const unsigned long long* ssr;
    bf16_t* BG; bf16_t* CV; float* convS; };
template <int MODE>
__device__ __forceinline__ int sk2_brow(int cg, int cb, int i) {
    if (MODE == SK_UP) return 128 * cg + 16 * cb + i;
    if (MODE == SK_RES) return 32 * cg + 16 * cb + i;
    const int sel = cb >> 1, c = 32 * cg + 16 * (cb & 1) + i;
    if (MODE == SK_GLU) return 256 * (c >> 7) + 128 * sel + (c & 127);
    return sel < 2 ? 256 * (c >> 7) + 128 * sel + (c & 127) : 2048 + c;
}
template <int MODE>
__device__ void skinny2d(const SkArgs& a, int b, unsigned char* lds) {
    constexpr int NCB = MODE == SK_UP ? 8 : MODE == SK_RES ? 2 : MODE == SK_GLU ? 4 : 6, NV = MODE == SK_UP ? 8 : 2, K = 1024;
    const int tid = tid_opaque(), w = __builtin_amdgcn_readfirstlane(tid >> 6), lane = tid & 63, fr = lane & 15, fq = lane >> 4;
    const int rb = b & 7, cg = b >> 3, ecb = tid >> 6, erow = 16 * rb + fr;
    const bool red = tid < NV * 64;
    f32x4 basev = (f32x4){0.f, 0.f, 0.f, 0.f}; unsigned long long ssv = 0ull;
    if (red) { if (MODE == SK_RES || MODE == SK_GLU) basev = *(const f32x4*)(a.baseS + (size_t)erow * 1024 + 32 * cg + 16 * ecb + 4 * fq); else ssv = a.ssr[erow]; }
    const bf16_t* ap = a.A + (size_t)erow * K + 128 * w + fq * 8;
    bf16x8 av[4], bv[NCB][4];
#pragma unroll
    for (int u = 0; u < 4; ++u) av[u] = *(const bf16x8*)(ap + u * 32);
#pragma unroll
    for (int cb = 0; cb < NCB; ++cb) { const bf16_t* bp = a.Bt + (size_t)sk2_brow<MODE>(cg, cb, fr) * K + 128 * w + fq * 8;
#pragma unroll
        for (int u = 0; u < 4; ++u) bv[cb][u] = *(const bf16x8*)(bp + u * 32); }
    f32x4* part = (f32x4*)lds;
#pragma unroll
    for (int cb = 0; cb < NCB; ++cb) { f32x4 acc = (f32x4){0.f, 0.f, 0.f, 0.f};
#pragma unroll
        for (int u = 0; u < 4; ++u) acc = __builtin_amdgcn_mfma_f32_16x16x32_bf16(bv[cb][u], av[u], acc, 0, 0, 0);
        part[(w * NCB + cb) * 64 + lane] = acc; }
    __syncthreads();
    if (red) {
        const float SSC = 1.0f / (1024.0f * 1048576.0f);
        f32x4 s0 = part[ecb * 64 + lane];
#pragma unroll
        for (int v = 1; v < 8; ++v) s0 = s0 + part[(v * NCB + ecb) * 64 + lane];
        if (MODE == SK_UP) {
            const float rs2 = __builtin_amdgcn_rcpf((float)ssv * SSC + EPS);
            float h[4];
#pragma unroll
            for (int j = 0; j < 4; ++j) { const float t = fmaxf(s0[j], 0.f); h[j] = t * t * rs2; }
            pg8::u32x2 o; o.x = cvt_pk_bf16(h[0], h[1]); o.y = cvt_pk_bf16(h[2], h[3]);
            *(pg8::u32x2*)(a.O + (size_t)erow * 4096 + 128 * cg + 16 * ecb + 4 * fq) = o;
        } else if (MODE == SK_RES || MODE == SK_GLU) {
            f32x4 val = s0;
            if (MODE == SK_GLU) { f32x4 s1 = part[(2 + ecb) * 64 + lane];
#pragma unroll
                for (int v = 1; v < 8; ++v) s1 = s1 + part[(v * NCB + 2 + ecb) * 64 + lane];
#pragma unroll
                for (int j = 0; j < 4; ++j) val[j] = s0[j] * __builtin_amdgcn_rcpf(1.0f + __expf(-s1[j])); }
            const f32x4 x = val + basev; const size_t o = (size_t)erow * 1024 + 32 * cg + 16 * ecb + 4 * fq;
            *(f32x4*)(a.X + o) = x;
            if (a.XB) { pg8::u32x2 w2; w2.x = cvt_pk_bf16(x[0], x[1]); w2.y = cvt_pk_bf16(x[2], x[3]); *(pg8::u32x2*)(a.XB + o) = w2; }
            float sq = (x[0] * x[0] + x[1] * x[1]) + (x[2] * x[2] + x[3] * x[3]);
            sq += __shfl_xor(sq, 16); sq += __shfl_xor(sq, 32);
            if (fq == 0) atomicAdd(a.ssw + erow, (unsigned long long)(sq * 1048576.0f + 0.5f));
        } else {
            f32x4 s1 = part[(2 + ecb) * 64 + lane], s2 = part[(4 + ecb) * 64 + lane];
#pragma unroll
            for (int v = 1; v < 8; ++v) { s1 = s1 + part[(v * NCB + 2 + ecb) * 64 + lane]; s2 = s2 + part[(v * NCB + 4 + ecb) * 64 + lane]; }
            const float rs2 = __builtin_amdgcn_rcpf((float)ssv * SSC + EPS);
            const size_t o = (size_t)erow * 1024 + 32 * cg + 16 * ecb + 4 * fq;
            const f32x4 cv = s0 * s1 * rs2, bg = s2 * __builtin_sqrtf(rs2);
            pg8::u32x2 w2; w2.x = cvt_pk_bf16(cv[0], cv[1]); w2.y = cvt_pk_bf16(cv[2], cv[3]);
            *(pg8::u32x2*)(a.CV + o) = w2;
            *(f32x4*)(a.convS + ((size_t)erow * 2 + 1) * 1024 + 32 * cg + 16 * ecb + 4 * fq) = cv;
            pg8::u32x2 w3; w3.x = cvt_pk_bf16(bg[0], bg[1]); w3.y = cvt_pk_bf16(bg[2], bg[3]);
            *(pg8::u32x2*)(a.BG + o) = w3;
        }
    }
    __syncthreads();
}
__device__ void skinny_down2d(const SkArgs& a, int b, unsigned char* lds) {
    const int tid = tid_opaque(), w = __builtin_amdgcn_readfirstlane(tid >> 6), lane = tid & 63, fr = lane & 15, fq = lane >> 4;
    constexpr int K = 4096;
    const int rb = b & 7, cg = b >> 3;
    const bf16_t* ap = a.A + (size_t)(16 * rb + fr) * K + 512 * w + fq * 8;
    const bf16_t* bp0 = a.Bt + (size_t)(32 * cg + fr) * K + 512 * w + fq * 8;
    const bf16_t* bp1 = bp0 + (size_t)16 * K;
    const int ecb = tid >> 6, erow = 16 * rb + fr, ecol = 32 * cg + 16 * ecb + 4 * fq;
    f32x4 basev = (f32x4){0.f, 0.f, 0.f, 0.f};
    if (tid < 128) basev = *(const f32x4*)(a.baseS + (size_t)erow * 1024 + ecol);
    f32x4 acc0 = (f32x4){0.f, 0.f, 0.f, 0.f}, acc1 = acc0;
#pragma unroll
    for (int h = 0; h < 2; ++h) {
        bf16x8 av[8], b0[8], b1[8];
#pragma unroll
        for (int u = 0; u < 8; ++u) { av[u] = *(const bf16x8*)(ap + (h * 8 + u) * 32); b0[u] = *(const bf16x8*)(bp0 + (h * 8 + u) * 32); b1[u] = *(const bf16x8*)(bp1 + (h * 8 + u) * 32); }
#pragma unroll
        for (int u = 0; u < 8; ++u) { acc0 = __builtin_amdgcn_mfma_f32_16x16x32_bf16(b0[u], av[u], acc0, 0, 0, 0); acc1 = __builtin_amdgcn_mfma_f32_16x16x32_bf16(b1[u], av[u], acc1, 0, 0, 0); }
    }
    f32x4* part = (f32x4*)lds;
    part[(w * 2 + 0) * 64 + lane] = acc0; part[(w * 2 + 1) * 64 + lane] = acc1;
    __syncthreads();
    if (tid < 128) {
        f32x4 s = part[(0 * 2 + ecb) * 64 + lane];
#pragma unroll
        for (int v = 1; v < 8; ++v) s = s + part[(v * 2 + ecb) * 64 + lane];
        const f32x4 x = s + basev; const size_t o = (size_t)erow * 1024 + ecol;
        *(f32x4*)(a.X + o) = x;
        if (a.XB) { pg8::u32x2 w2; w2.x = cvt_pk_bf16(x[0], x[1]); w2.y = cvt_pk_bf16(x[2], x[3]); *(pg8::u32x2*)(a.XB + o) = w2; }
        float sq = (x[0] * x[0] + x[1] * x[1]) + (x[2] * x[2] + x[3] * x[3]);
        sq += __shfl_xor(sq, 16); sq += __shfl_xor(sq, 32);
        if (fq == 0) atomicAdd(a.ssw + erow, (unsigned long long)(sq * 1048576.0f + 0.5f));
    }
    __syncthreads();
}
__device__ __forceinline__ void unpack8(const u32x4 v, float* f) { f[0] = __uint_as_float(v.x << 16); f[1] = __uint_as_float(v.x & 0xffff0000u); f[2] = __uint_as_float(v.y << 16); f[3] = __uint_as_float(v.y & 0xffff0000u);
    f[4] = __uint_as_float(v.z << 16); f[5] = __uint_as_float(v.z & 0xffff0000u); f[6] = __uint_as_float(v.w << 16); f[7] = __uint_as_float(v.w & 0xffff0000u); }
__device__ void convgate_wg(KP p, int j, int wg) {
    const int tid = tid_opaque(), c = (tid & 127) * 8, strip = tid >> 7;
    const bf16_t* BG = (const bf16_t*)(p->ws + WS_ACT + A_BG); const bf16_t* CV = (const bf16_t*)(p->ws + WS_ACT + A_CV); bf16_t* Z = (bf16_t*)(p->ws + WS_ACT + A_Z);
    const float* cw = p->in[18] + (size_t)j * 3 * D + c;
    float w0[8], w1[8], w2[8];
#pragma unroll
    for (int q = 0; q < 8; ++q) { w0[q] = cw[q]; w1[q] = cw[D + q]; w2[q] = cw[2 * D + q]; }
    const int r0 = wg * 64 + strip * 16;
    float x0[8], x1[8];
    if ((r0 & 2047) != 0) { unpack8(*(const u32x4*)(CV + (size_t)(r0 - 2) * D + c), x0); unpack8(*(const u32x4*)(CV + (size_t)(r0 - 1) * D + c), x1); }
    else {
#pragma unroll
        for (int q = 0; q < 8; ++q) { x0[q] = 0.f; x1[q] = 0.f; } }
#pragma unroll
    for (int h = 0; h < 2; ++h) { u32x4 cv[8], bg[8];
#pragma unroll
        for (int i = 0; i < 8; ++i) { const size_t o = (size_t)(r0 + h * 8 + i) * D + c; cv[i] = *(const u32x4*)(CV + o); bg[i] = *(const u32x4*)(BG + o); }
#pragma unroll
        for (int i = 0; i < 8; ++i) { float x2[8], b[8], z[8]; unpack8(cv[i], x2); unpack8(bg[i], b);
#pragma unroll
            for (int q = 0; q < 8; ++q) { z[q] = b[q] * (w0[q] * x0[q] + w1[q] * x1[q] + w2[q] * x2[q]); x0[q] = x1[q]; x1[q] = x2[q]; }
            u32x4 w; w.x = cvt_pk_bf16(z[0], z[1]); w.y = cvt_pk_bf16(z[2], z[3]); w.z = cvt_pk_bf16(z[4], z[5]); w.w = cvt_pk_bf16(z[6], z[7]);
            *(u32x4*)(Z + (size_t)(r0 + h * 8 + i) * D + c) = w; } }
    if (wg < MS && strip == 0) { const int i = wg; const size_t r = (size_t)MP + i;
        const float* sb = p->in[4] + (((size_t)j * MS + i) * 2) * D + c; float* so = p->out + O_CVS + (((size_t)j * MS + i) * 2) * D + c;
        float x2[8], b[8], z[8]; unpack8(*(const u32x4*)(CV + r * D + c), x2); unpack8(*(const u32x4*)(BG + r * D + c), b);
#pragma unroll
        for (int q = 0; q < 8; ++q) { const float s0 = sb[q], s1 = sb[D + q]; so[q] = s1; z[q] = b[q] * (w0[q] * s0 + w1[q] * s1 + w2[q] * x2[q]); }
        u32x4 w; w.x = cvt_pk_bf16(z[0], z[1]); w.y = cvt_pk_bf16(z[2], z[3]); w.z = cvt_pk_bf16(z[4], z[5]); w.w = cvt_pk_bf16(z[6], z[7]);
        *(u32x4*)(Z + r * D + c) = w; }
}
__device__ void final_unit16(KP p, int unit) {
    const int tid = tid_opaque(), c = (tid & 127) * 8;
    const unsigned long long* ss = (const unsigned long long*)(p->ws + WS_SS) + 7 * (size_t)MPAD;
    const float* g = p->in[7] + c; const f32x4 g0 = *(const f32x4*)g, g1 = *(const f32x4*)(g + 4);
    f32x4 v0[4], v1[4]; float rstd[4];
#pragma unroll
    for (int i = 0; i < 4; ++i) { const int r = unit * 16 + i * 4 + (tid >> 7); const float* x = p->out + (size_t)r * D + c; v0[i] = *(const f32x4*)x; v1[i] = *(const f32x4*)(x + 4);
        rstd[i] = rsqrtf((float)ss[r] * (1.0f / (1024.0f * 1048576.0f)) + EPS); }
#pragma unroll
    for (int i = 0; i < 4; ++i) { const int r = unit * 16 + i * 4 + (tid >> 7); float* x = p->out + (size_t)r * D + c;
        *(f32x4*)x = v0[i] * rstd[i] * g0; *(f32x4*)(x + 4) = v1[i] * rstd[i] * g1; }
}

__device__ void decode_final_tail(KP p, int b, unsigned* cnt) {
    const int tid = tid_opaque(), lane = tid & 63, fr = lane & 15, fq = lane >> 4;
    if (tid == 0) { unsigned sp = 0; while (__hip_atomic_load(cnt, __ATOMIC_RELAXED, __HIP_MEMORY_SCOPE_AGENT) < 256u) { __builtin_amdgcn_s_sleep(2); if (++sp > (1u << 22)) break; } }
    __syncthreads();
    if (tid < 128) { const int rb = b & 7, cg = b >> 3, erow = MP + 16 * rb + fr, ecol = 32 * cg + 16 * (tid >> 6) + 4 * fq;
        const unsigned long long* ss = (const unsigned long long*)(p->ws + WS_SS) + 7 * (size_t)MPAD;
        const unsigned long long sv = __hip_atomic_load(ss + erow, __ATOMIC_RELAXED, __HIP_MEMORY_SCOPE_AGENT);
        const float rstd = rsqrtf((float)sv * (1.0f / (1024.0f * 1048576.0f)) + EPS);
        float* x = p->out + (size_t)erow * D + ecol;
        *(f32x4*)x = *(const f32x4*)x * rstd * *(const f32x4*)(p->in[7] + ecol); }
}

__global__ void __launch_bounds__(NTHR) fwd_kernel(Params p_) {
    KP p = (KP)__builtin_amdgcn_kernarg_segment_ptr();
    extern __shared__ __attribute__((aligned(16))) unsigned char lds[];
    cg::grid_group grid = cg::this_grid();
    const int bid = blockIdx.x, G = gridDim.x, tid = threadIdx.x;
    const int ph_lo = p->ph_lo, ph_hi = p->ph_hi;
    volatile LAS unsigned* xst = (volatile LAS unsigned*)((LAS unsigned char*)lds + LDS_TOTAL);
    if (threadIdx.x < 4) xst[threadIdx.x] = 0u;
    __syncthreads();
    XcdBarrier xbar; xbar.bar = (unsigned*)(p->ws + WS_BAR); xbar.x = 0; xbar.st = xst;
    if (ph_hi - ph_lo > 1) xbar = xcd_barrier_post((unsigned*)(p->ws + WS_BAR), xst);
    for (int ph = ph_lo; ph < ph_hi; ++ph) {
        if (ph == 2 || ph == 3 || ph == 12 || ph == 14 || ph == 15 || (ph == 24 && G == 256)) continue;
      {
        asm volatile("" : "+s"(p));
        unsigned char* ws = p->ws;
        unsigned long long* SS = (unsigned long long*)(ws + WS_SS);
        bf16_t* XB = (bf16_t*)(ws + WS_XB);
        const int L = (ph - 1) / 12 * 2;
        const int rel = ph == 0 ? 0 : (ph - 1) % 12 + 1;
        const int jj = L >> 1;
        if (ph == 24) {
            for (int u = (G == 256 ? MP / 16 : 0) + bid; u < MR / 16; u += G) final_unit16(p, u);
        } else if (ph == 0) {
            for (int i = bid * NTHR + tid_opaque(); i < 8 * MPAD; i += G * NTHR) SS[i] = 0ull;
            for (int step = 0; step < 2; ++step) {
              if (((step ^ bid) & 1) == 0) { for (int u = bid; u < NG * 4; u += G) ssm_gen_unit(p, 0, u, lds, (bf16_t*)(ws + WS_ACT + A_WG), (bf16_t*)(ws + WS_ACT + A_TV), ws + WS_PAR); }
              else { for (int u = bid; u < MR / 16; u += G) rowss_unit(p, u, lds); } }
        } else if (rel == 1) {
            const bf16_t* WGm = (jj == 0) ? (const bf16_t*)(ws + WS_ACT + A_WG) : (const bf16_t*)(ws + WS_WG1);
            const bf16_t* TVm = (jj == 0) ? (const bf16_t*)(ws + WS_ACT + A_TV) : (const bf16_t*)(ws + WS_TV1);
            const unsigned char* par = ws + WS_PAR + (size_t)jj * PAR_BYTES;
            const float* srcS = (jj == 0) ? p->in[1] : p->out + (size_t)MP * D;
            const unsigned long long* ssrc = SS + (size_t)(jj == 0 ? 8 : 3) * MPAD;
            const float* gain = p->in[5] + (size_t)(2 * jj) * D;
            for (int step = 0; step < 2; ++step) {
              const bool mix = (ph == 1) ? (((step ^ bid) & 1) == 0) : (step == 0);
              if (mix) {
                for (int u = bid; u < NG * 4; u += G) s5_unit(p, jj, ((u >> 3) & 31) + 32 * ((u >> 2) & 1), 2 * (u & 3), WGm, TVm, par, (const bf16_t*)XB, ssrc, gain, lds);
                for (int u = bid; u < 256; u += G) s5_sample_wg(p, jj, u, par, srcS, ssrc + MP, gain);
              } else if (ph == 1) {
                for (int jb = 0; jb < 14; ++jb) {
                    const float* W; bf16_t* Bt; const float* sc = nullptr; int K, N, mode = 0;
                    if (jb < 2) { W = p->in[16] + (size_t)jb * 1024 * 2048; Bt = (bf16_t*)(ws + W_GLU(jb)); K = 1024; N = 2048; mode = 1; }
                    else if (jb < 6) { const int i = jb - 2; W = p->in[20] + (size_t)i * 1024 * 4096; Bt = (bf16_t*)(ws + W_UP(i)); K = 1024; N = 4096; sc = p->in[6] + (size_t)i * D; }
                    else if (jb < 10) { const int i = jb - 6; W = p->in[21] + (size_t)i * 4096 * 1024; Bt = (bf16_t*)(ws + W_DOWN(i)); K = 4096; N = 1024; }
                    else if (jb < 12) { const int i = jb - 10; W = p->in[17] + (size_t)i * 1024 * 3072; Bt = (bf16_t*)(ws + W_IN(i)); K = 1024; N = 3072; mode = 2; sc = p->in[5] + (size_t)(2 * i + 1) * D; }
                    else { const int i = jb - 12; W = p->in[19] + (size_t)i * 1024 * 1024; Bt = (bf16_t*)(ws + W_OUT(i)); K = 1024; N = 1024; }
                    const int ntiles = (K >> 6) * (N >> 6);
                    const int off = (jb == 1) ? 128 : (jb == 11) ? 192 : (jb == 12) ? 128 : (jb == 13) ? 192 : 0;
                    transpose_job(W, Bt, sc, K, N, mode, (bid + G - off % G) % G, G, ntiles / 4, (float*)lds);
                }
              }
            }
        } else if (rel == 8) {
            for (int step = 0; step < 2; ++step) {
              if (((step ^ bid) & 1) == 0) { for (int u = bid; u < 256; u += G) convgate_wg(p, jj, u); }
              else if (ph == 8) { for (int u = bid; u < NG * 4; u += G) ssm_gen_unit(p, 1, u, lds, (bf16_t*)(ws + WS_WG1), (bf16_t*)(ws + WS_TV1), ws + WS_PAR + PAR_BYTES); } }
        } else {
            pg8::StaticOrder S; pg8::Gemm g;
            PG8_LAS unsigned char* l3 = (PG8_LAS unsigned char*)lds;
            if (rel == 4) {
                g = pg8::Gemm{(const bf16_t*)(ws + WS_ACT + A_YACT), (const bf16_t*)(ws + W_GLU(jj)), MP, 2048, 1024};
                S.init(MP, 2048, G, bid);
                { SkArgs a{}; a.A = g.A + (size_t)MP * 1024; a.Bt = g.Bt; a.K = 1024; a.baseS = (L == 0) ? p->in[1] : p->out + (size_t)MP * D; a.X = p->out + (size_t)MP * D; a.XB = XB + (size_t)MP * D; a.ssw = SS + (size_t)(L * 2) * MPAD + MP;
                  for (int sb = bid; sb < 256; sb += G) skinny2d<SK_GLU>(a, sb, lds); }
                pg8::EpiGlu E{L == 0 ? p->in[0] : p->out, L == 0 ? p->in[1] : p->out + (size_t)MP * D, p->out, XB, SS + (size_t)(L * 2) * MPAD};
                pg8::gemm_phase<pg8::EpiGlu, pg8::StaticOrder, GEMM_ALIGN, GEMM_SP2>(l3, g, S, E);
            } else if (rel == 5 || rel == 10) {
                const int layer = L + (rel == 10), ssi = layer * 2;
                g = pg8::Gemm{XB, (const bf16_t*)(ws + W_UP(layer)), MP, 4096, 1024};
                S.init(MP, 4096, G, bid);
                { SkArgs a{}; a.A = g.A + (size_t)MP * 1024; a.Bt = g.Bt; a.K = 1024; a.O = (bf16_t*)(ws + WS_ACT) + (size_t)MP * 4096; a.ssr = SS + (size_t)ssi * MPAD + MP;
                  for (int sb = bid; sb < 256; sb += G) skinny2d<SK_UP>(a, sb, lds); }
                pg8::EpiUp E{(bf16_t*)(ws + WS_ACT), 4096, SS + (size_t)ssi * MPAD};
                pg8::gemm_phase<pg8::EpiUp, pg8::StaticOrder, GEMM_ALIGN, GEMM_SP2>(l3, g, S, E);
            } else if (rel == 6 || rel == 11 || rel == 9) {
                const int layer = L + (rel != 6);
                const int ssi = (rel == 9) ? layer * 2 : layer * 2 + 1;
                if (rel == 9) { g = pg8::Gemm{(const bf16_t*)(ws + WS_ACT + A_Z), (const bf16_t*)(ws + W_OUT(jj)), MP, 1024, 1024}; }
                else { g = pg8::Gemm{(const bf16_t*)(ws + WS_ACT), (const bf16_t*)(ws + W_DOWN(layer)), MP, 1024, 4096}; }
                S.init(MP, 1024, G, bid);
                { SkArgs a{}; a.A = g.A + (size_t)MP * g.K; a.Bt = g.Bt; a.K = g.K; a.baseS = p->out + (size_t)MP * D; a.X = p->out + (size_t)MP * D; a.XB = (ph == 11) ? nullptr : XB + (size_t)MP * D; a.ssw = SS + (size_t)ssi * MPAD + MP;
                  if (g.K == 1024) { for (int sb = bid; sb < 256; sb += G) skinny2d<SK_RES>(a, sb, lds); } else { for (int sb = bid; sb < 256; sb += G) skinny_down2d(a, sb, lds); }
                  if (ph == 23 && G == 256) {
                      asm volatile("s_waitcnt vmcnt(0)" ::: "memory"); __syncthreads();
                      if (threadIdx.x == 0) __hip_atomic_fetch_add((unsigned*)(ws + WS_CNT) + 32, 1u, __ATOMIC_RELAXED, __HIP_MEMORY_SCOPE_AGENT); } }
                if (ph == 23 && G == 256) { pg8::EpiResFinal EF{p->out, p->out, p->in[7], SS + (size_t)ssi * MPAD, (unsigned*)(ws + WS_CNT)};
                    pg8::gemm_phase<pg8::EpiResFinal, pg8::StaticOrder, false, GEMM_SP2>(l3, g, S, EF);
                    decode_final_tail(p, bid, (unsigned*)(ws + WS_CNT) + 32); } else {
                pg8::EpiRes E{p->out, p->out + (size_t)MP * D, p->out, XB, SS + (size_t)ssi * MPAD, ph == 11 ? 1 : 0};
                pg8::gemm_phase<pg8::EpiRes, pg8::StaticOrder, GEMM_ALIGN, GEMM_SP2>(l3, g, S, E); }
            } else {
                g = pg8::Gemm{XB, (const bf16_t*)(ws + W_IN(jj)), MP, 3072, 1024};
                S.init(MP, 3072, G, bid);
                { SkArgs a{}; a.A = g.A + (size_t)MP * 1024; a.Bt = g.Bt; a.K = 1024; a.ssr = SS + (size_t)(L * 2 + 1) * MPAD + MP; a.BG = (bf16_t*)(ws + WS_ACT + A_BG) + (size_t)MP * D; a.CV = (bf16_t*)(ws + WS_ACT + A_CV) + (size_t)MP * D; a.convS = p->out + O_CVS + (size_t)jj * MS * 2 * D;
                  for (int sb = bid; sb < 256; sb += G) skinny2d<SK_WIN>(a, sb, lds); }
                pg8::EpiWin E{(bf16_t*)(ws + WS_ACT + A_BG), (bf16_t*)(ws + WS_ACT + A_CV), SS + (size_t)(L * 2 + 1) * MPAD, p->out + O_CVP + (size_t)jj * 8 * 2 * D, p->out + O_CVS + (size_t)jj * MS * 2 * D};
                pg8::gemm_phase<pg8::EpiWin, pg8::StaticOrder, GEMM_ALIGN, GEMM_SP2>(l3, g, S, E);
            }
        }
      }
        if (ph_hi > 1000) grid.sync();
        if (ph + 1 < ph_hi && !(ph == 23 && G == 256)) xcd_barrier(xbar);
    }
}

extern "C" void kernel_launch(void* const* d_in, const int* in_sizes, int n_in, void* d_out, int out_size, void* d_ws, size_t ws_size, hipStream_t stream) {
    static int grid = 0;
    if (grid == 0) {
        if (n_in != 22 || ws_size < WS_END) { fprintf(stderr, "kernel_launch: need 22 inputs and %zu bytes of workspace; got %d, %zu\n", (size_t)WS_END, n_in, ws_size); grid = -1; return; }
        int dev = 0, cus = 0, per_cu = 0;
        hipGetDevice(&dev); hipDeviceGetAttribute(&cus, hipDeviceAttributeMultiprocessorCount, dev);
        if (hipFuncSetAttribute((const void*)fwd_kernel, hipFuncAttributeMaxDynamicSharedMemorySize, LDS_TOTAL + 16 + 4096) != hipSuccess) { fprintf(stderr, "kernel_launch: hipFuncSetAttribute failed\n"); grid = -1; return; }
        if (hipOccupancyMaxActiveBlocksPerMultiprocessor(&per_cu, (const void*)fwd_kernel, NTHR, LDS_TOTAL + 16 + 4096) != hipSuccess || per_cu < 1) { fprintf(stderr, "kernel_launch: occupancy query says %d\n", per_cu); (void)hipGetLastError(); per_cu = 1; }
        grid = cus;
    }
    if (grid < 0) return;
    Params p{};
    for (int i = 0; i < 22; ++i) p.in[i] = (const float*)d_in[i];
    p.out = (float*)d_out; p.ws = (unsigned char*)d_ws;
#if defined(MULTI_LAUNCH)
    for (int ph = 0; ph < 25; ++ph) { p.ph_lo = ph; p.ph_hi = ph + 1; hipLaunchKernelGGL(fwd_kernel, dim3(grid), dim3(NTHR), LDS_TOTAL + 16 + 4096, stream, p); }
#else
    p.ph_lo = 0; p.ph_hi = 25;
    if (hipMemsetAsync((char*)d_ws + WS_BAR, 0, 32768, stream) != hipSuccess) { fprintf(stderr, "kernel_launch: memset failed\n"); return; }
    void* args[] = {&p};
    hipError_t e = hipLaunchCooperativeKernel((const void*)fwd_kernel, dim3(grid), dim3(NTHR), args, LDS_TOTAL + 16 + 4096, stream);
    if (e != hipSuccess) fprintf(stderr, "cooperative launch failed: %s (grid %d)\n", hipGetErrorString(e), grid);
#endif
}
```

```cpp
#include <hip/hip_runtime.h>
#include <hip/hip_cooperative_groups.h>
#include <cstdio>
namespace pg8 {
#define PG8_LAS __attribute__((address_space(3)))
typedef unsigned short bf16_t;
typedef short bf16x8 __attribute__((ext_vector_type(8)));
typedef float f32x4 __attribute__((ext_vector_type(4)));
typedef unsigned u32x4 __attribute__((ext_vector_type(4)));
constexpr int BM = 256, BK = 64, HALF = 128, HTB = HALF * BK * 2  , STAGE_BYTES = 8 * HTB, NXCD = 8, WGM = 4;

__host__ __device__ __forceinline__ int lds_byte(int r, int c) { const int st = (r >> 4) * 2 + (c >> 5), rr = r & 15, cc = c & 31, ob = rr * 64 + cc * 2; return st * 1024 + (ob ^ (((ob >> 9) & 1) << 5)); }
__host__ __device__ __forceinline__ void stage_rc(int b, int& R, int& C) { const int st = b / 1024, sb = b % 1024, swz = sb ^ (((sb >> 9) & 1) << 5); R = (st >> 1) * 16 + swz / 64; C = (st & 1) * 32 + (swz % 64) / 2; }
__host__ __device__ __forceinline__ int perm32(int rho) { const int n = rho >> 4, i = rho & 15; return 8 * (i >> 2) + 4 * n + (i & 3); }

struct Unit { int pm, pn; };
struct Gemm { const bf16_t* A; const bf16_t* Bt; int M, N, K; };

struct StaticOrder {
    int nM, nN, nwg, G, c;
    __host__ __device__ void init(int M, int N, int G_, int c_) { nM = M / BM; nN = N / BM; nwg = nM * nN; G = G_; c = c_; }
    __host__ __device__ bool next(int i, Unit& u) const {
        const long L = (long)i * G + c; if (L >= nwg) return false;
        int wgid = (int)L; { const int q = nwg / NXCD, r = nwg % NXCD, xcd = wgid % NXCD, off = wgid / NXCD; wgid = (xcd < r ? xcd * (q + 1) : r * (q + 1) + (xcd - r) * q) + off; }
        const int nig = WGM * nN, gid = wgid / nig, fm = gid * WGM, gsz = (nM - fm) < WGM ? (nM - fm) : WGM;
        u.pm = fm + ((wgid % nig) % gsz); u.pn = (wgid % nig) / gsz; return true;
    }
    __device__ __forceinline__ void a_ready(const Unit&) const {}
    __device__ __forceinline__ void done(const Unit&) const {}
};
struct CountedOrder : StaticOrder {
    const unsigned* ready; unsigned need; unsigned* tmo;
    __device__ __forceinline__ void a_ready(const Unit& u) const {
        if (threadIdx.x < 64) {
            const unsigned long long t0 = __builtin_amdgcn_s_memrealtime(); unsigned polls = 0;
            while ((unsigned)__builtin_amdgcn_readfirstlane(__hip_atomic_load(ready + 64 * u.pm, __ATOMIC_RELAXED, __HIP_MEMORY_SCOPE_AGENT)) < need) {
                if ((++polls & 255u) == 0u && __builtin_amdgcn_readfirstlane(__hip_atomic_load(tmo, __ATOMIC_RELAXED, __HIP_MEMORY_SCOPE_AGENT)) != 0u) break;
                if (__builtin_amdgcn_s_memrealtime() - t0 > 2000000ull) {
                    if (threadIdx.x == 0) { unsigned expect = 0u; __hip_atomic_compare_exchange_strong(tmo + 1, &expect, 0x600u | (unsigned)(u.pm & 0xff), __ATOMIC_RELAXED, __ATOMIC_RELAXED, __HIP_MEMORY_SCOPE_AGENT); __hip_atomic_store(tmo, 1u, __ATOMIC_RELAXED, __HIP_MEMORY_SCOPE_AGENT); }
                    break; }
                __builtin_amdgcn_s_sleep(2); }
            __builtin_amdgcn_fence(__ATOMIC_ACQUIRE, "agent");
            asm volatile("s_waitcnt vmcnt(0)" ::: "memory");
        }
#if !defined(BROKEN_HOOK_NO_BARRIER)
        asm volatile("" ::: "memory"); __builtin_amdgcn_s_barrier(); asm volatile("" ::: "memory");
#endif
    }
};

__device__ __forceinline__ unsigned cvt_pk_bf16(float lo, float hi) { unsigned r; asm volatile("v_cvt_pk_bf16_f32 %0, %1, %2" : "=v"(r) : "v"(lo), "v"(hi)); return r; }
typedef float f32x2 __attribute__((ext_vector_type(2)));
__device__ __forceinline__ f32x2 gelu_pk(f32x2 v) {
    const f32x2 av = __builtin_elementwise_abs(v), d = av * 0.2316418882f + 1.0f;
    f32x2 t; t.x = __builtin_amdgcn_rcpf(d.x); t.y = __builtin_amdgcn_rcpf(d.y);
    f32x2 q = t * 0.5307027145f + (-0.7265760135f); q = q * t + 0.7107068705f; q = q * t + (-0.142248368f); q = q * t + 0.127414796f; q = q * t;
    const f32x2 s = (v * v) * (-0.72134752044f);
    f32x2 e; e.x = __builtin_amdgcn_exp2f(s.x); e.y = __builtin_amdgcn_exp2f(s.y);
    const f32x2 m = v * (q * e), r = v - m;
    f32x2 o; o.x = v.x < 0.f ? m.x : r.x; o.y = v.y < 0.f ? m.y : r.y; return o;
}

constexpr int MPR = 16384, MRR = 16512;
constexpr float RMS_EPS_ = 1e-6f;
typedef unsigned u32x2 __attribute__((ext_vector_type(2)));
__device__ __forceinline__ float sigmoidf_(float z) { return __builtin_amdgcn_rcpf(1.0f + __expf(-z)); }

struct EpiUp {
    static constexpr bool PERM = true, AFTER_DRAIN = false;
    bf16_t* O; int ldc; const unsigned long long* ss;
    __device__ __forceinline__ void operator()(const f32x4 (&acc)[2][2][4][2], const Unit& u, int wr, int wc, int fr, int fq) const {
        const int row0 = u.pm * BM + wr * 64 + fr, col0 = u.pn * BM + wc * 32 + 8 * fq;
        unsigned long long sv[2][4];
#pragma unroll
        for (int ai = 0; ai < 2; ++ai)
#pragma unroll
            for (int m = 0; m < 4; ++m) sv[ai][m] = ss[row0 + ai * HALF + m * 16];
#pragma unroll
        for (int ai = 0; ai < 2; ++ai)
#pragma unroll
            for (int m = 0; m < 4; ++m) { const int r = row0 + ai * HALF + m * 16; const float rs2 = __builtin_amdgcn_rcpf((float)sv[ai][m] * (1.0f / (1024.0f * 1048576.0f)) + RMS_EPS_);
                bf16_t* rowp = O + (size_t)r * ldc + col0;
#pragma unroll
                for (int bj = 0; bj < 2; ++bj) { f32x4 v0 = acc[ai][bj][m][0], v1 = acc[ai][bj][m][1];
#pragma unroll
                    for (int j = 0; j < 4; ++j) { const float a = fmaxf(v0[j], 0.f), b = fmaxf(v1[j], 0.f); v0[j] = a * a * rs2; v1[j] = b * b * rs2; }
                    u32x4 w; w.x = cvt_pk_bf16(v0[0], v0[1]); w.y = cvt_pk_bf16(v0[2], v0[3]); w.z = cvt_pk_bf16(v1[0], v1[1]); w.w = cvt_pk_bf16(v1[2], v1[3]);
                    *(u32x4*)(rowp + bj * HALF) = w; } }
    }
};
struct EpiRes {
    static constexpr bool PERM = true, AFTER_DRAIN = false;
    const float* baseP; const float* baseS; float* X; bf16_t* XB; unsigned long long* ss; int gm;
    __device__ __forceinline__ void operator()(const f32x4 (&acc)[2][2][4][2], const Unit& u, int wr, int wc, int fr, int fq) const {
        const int row0 = u.pm * BM + wr * 64 + fr, col0 = u.pn * BM + wc * 32 + 8 * fq;
#pragma unroll
        for (int ai = 0; ai < 2; ++ai) { if (u.pm * BM + ai * HALF >= MRR) continue;
            f32x4 bv[4][2][2];
#pragma unroll
            for (int m = 0; m < 4; ++m) { const int r = row0 + ai * HALF + m * 16;
                const float* bp = (r < MPR) ? baseP + (size_t)r * 1024 : baseS + (size_t)(r - MPR) * 1024;
#pragma unroll
                for (int bj = 0; bj < 2; ++bj) { bv[m][bj][0] = *(const f32x4*)(bp + col0 + bj * HALF); bv[m][bj][1] = *(const f32x4*)(bp + col0 + bj * HALF + 4); } }
#pragma unroll
            for (int m = 0; m < 4; ++m) { const int r = row0 + ai * HALF + m * 16;
                float sq = 0.f;
#pragma unroll
                for (int bj = 0; bj < 2; ++bj) { const int c = col0 + bj * HALF;
                    const f32x4 v0 = acc[ai][bj][m][0] + bv[m][bj][0], v1 = acc[ai][bj][m][1] + bv[m][bj][1];
                    *(f32x4*)(X + (size_t)r * 1024 + c) = v0; *(f32x4*)(X + (size_t)r * 1024 + c + 4) = v1;
                    u32x4 w; w.x = cvt_pk_bf16(v0[0], v0[1]); w.y = cvt_pk_bf16(v0[2], v0[3]); w.z = cvt_pk_bf16(v1[0], v1[1]); w.w = cvt_pk_bf16(v1[2], v1[3]);
                    if (gm) *(u32x4*)(XB + ((size_t)(c >> 4) * 16640 + r) * 16 + (c & 8)) = w; else *(u32x4*)(XB + (size_t)r * 1024 + c) = w;
                    sq += (v0[0] * v0[0] + v0[1] * v0[1]) + (v0[2] * v0[2] + v0[3] * v0[3]) + (v1[0] * v1[0] + v1[1] * v1[1]) + (v1[2] * v1[2] + v1[3] * v1[3]); }
                sq += __shfl_xor(sq, 16); sq += __shfl_xor(sq, 32);
                if (fq == 0) atomicAdd(ss + r, (unsigned long long)(sq * 1048576.0f + 0.5f)); } }
    }
};
struct EpiResFinal {
    static constexpr bool PERM = true, AFTER_DRAIN = true;
    const float* base; float* out; const float* gain; unsigned long long* ss; unsigned* cnt;
    __device__ __forceinline__ void operator()(const f32x4 (&)[2][2][4][2], const Unit&, int, int, int, int) const {}
    __device__ __forceinline__ void fused(f32x4 (&acc)[2][2][4][2], const Unit& u, int wr, int wc, int fr, int fq, PG8_LAS unsigned char* lds, int wid, int lane) const {
        const int row0 = u.pm * BM + wr * 64 + fr, col0 = u.pn * BM + wc * 32 + 8 * fq;
#pragma unroll
        for (int ai = 0; ai < 2; ++ai) {
            f32x4 bv[4][2][2];
#pragma unroll
            for (int m = 0; m < 4; ++m) { const float* bp = base + (size_t)(row0 + ai * HALF + m * 16) * 1024;
#pragma unroll
                for (int bj = 0; bj < 2; ++bj) { bv[m][bj][0] = *(const f32x4*)(bp + col0 + bj * HALF); bv[m][bj][1] = *(const f32x4*)(bp + col0 + bj * HALF + 4); } }
#pragma unroll
            for (int m = 0; m < 4; ++m) { const int r = row0 + ai * HALF + m * 16; float sq = 0.f;
#pragma unroll
                for (int bj = 0; bj < 2; ++bj) { const f32x4 v0 = acc[ai][bj][m][0] + bv[m][bj][0], v1 = acc[ai][bj][m][1] + bv[m][bj][1]; acc[ai][bj][m][0] = v0; acc[ai][bj][m][1] = v1;
                    sq += (v0[0] * v0[0] + v0[1] * v0[1]) + (v0[2] * v0[2] + v0[3] * v0[3]) + (v1[0] * v1[0] + v1[1] * v1[1]) + (v1[2] * v1[2] + v1[3] * v1[3]); }
                sq += __shfl_xor(sq, 16); sq += __shfl_xor(sq, 32);
                if (fq == 0) atomicAdd(ss + r, (unsigned long long)(sq * 1048576.0f + 0.5f)); } }
        asm volatile("s_waitcnt vmcnt(0)" ::: "memory");
        __builtin_amdgcn_s_barrier();
        if (wid == 0 && lane == 0) {
            __hip_atomic_fetch_add(cnt + 64 * u.pm, 1u, __ATOMIC_RELAXED, __HIP_MEMORY_SCOPE_AGENT);
            unsigned sp = 0;
            while (__hip_atomic_load(cnt + 64 * u.pm, __ATOMIC_RELAXED, __HIP_MEMORY_SCOPE_AGENT) < 4u) { __builtin_amdgcn_s_sleep(2); if (++sp > (1u << 22)) break; }
        }
        asm volatile("s_waitcnt vmcnt(0) lgkmcnt(0)" ::: "memory");
        __builtin_amdgcn_s_barrier();
        asm volatile("" ::: "memory");
        f32x4 g[2][2];
#pragma unroll
        for (int bj = 0; bj < 2; ++bj) { g[bj][0] = *(const f32x4*)(gain + col0 + bj * HALF); g[bj][1] = *(const f32x4*)(gain + col0 + bj * HALF + 4); }
        unsigned long long sv[2][4];
#pragma unroll
        for (int ai = 0; ai < 2; ++ai)
#pragma unroll
            for (int m = 0; m < 4; ++m) sv[ai][m] = __hip_atomic_load(ss + row0 + ai * HALF + m * 16, __ATOMIC_RELAXED, __HIP_MEMORY_SCOPE_AGENT);
#pragma unroll
        for (int ai = 0; ai < 2; ++ai)
#pragma unroll
            for (int m = 0; m < 4; ++m) { const int r = row0 + ai * HALF + m * 16; const float rstd = rsqrtf((float)sv[ai][m] * (1.0f / (1024.0f * 1048576.0f)) + RMS_EPS_);
#pragma unroll
                for (int bj = 0; bj < 2; ++bj) { float* o = out + (size_t)r * 1024 + col0 + bj * HALF;
                    *(f32x4*)o = acc[ai][bj][m][0] * rstd * g[bj][0]; *(f32x4*)(o + 4) = acc[ai][bj][m][1] * rstd * g[bj][1]; } }
    }
};
struct EpiGlu {
    static constexpr bool PERM = true, AFTER_DRAIN = false;
    const float* baseP; const float* baseS; float* X; bf16_t* XB; unsigned long long* ss;
    __device__ __forceinline__ void operator()(const f32x4 (&acc)[2][2][4][2], const Unit& u, int wr, int wc, int fr, int fq) const {
        const int row0 = u.pm * BM + wr * 64 + fr, c = u.pn * HALF + wc * 32 + 8 * fq;
        f32x4 bv[2][4][2];
#pragma unroll
        for (int ai = 0; ai < 2; ++ai)
#pragma unroll
            for (int m = 0; m < 4; ++m) { const int r = row0 + ai * HALF + m * 16;
                const float* bp = (r < MPR) ? baseP + (size_t)r * 1024 : baseS + (size_t)(r - MPR) * 1024;
                bv[ai][m][0] = *(const f32x4*)(bp + c); bv[ai][m][1] = *(const f32x4*)(bp + c + 4); }
#pragma unroll
        for (int ai = 0; ai < 2; ++ai)
#pragma unroll
            for (int m = 0; m < 4; ++m) { const int r = row0 + ai * HALF + m * 16;
                f32x4 v0 = bv[ai][m][0], v1 = bv[ai][m][1];
#pragma unroll
                for (int j = 0; j < 4; ++j) { v0[j] += acc[ai][0][m][0][j] * sigmoidf_(acc[ai][1][m][0][j]); v1[j] += acc[ai][0][m][1][j] * sigmoidf_(acc[ai][1][m][1][j]); }
                *(f32x4*)(X + (size_t)r * 1024 + c) = v0; *(f32x4*)(X + (size_t)r * 1024 + c + 4) = v1;
                u32x4 w; w.x = cvt_pk_bf16(v0[0], v0[1]); w.y = cvt_pk_bf16(v0[2], v0[3]); w.z = cvt_pk_bf16(v1[0], v1[1]); w.w = cvt_pk_bf16(v1[2], v1[3]);
                *(u32x4*)(XB + (size_t)r * 1024 + c) = w;
                float sq = (v0[0] * v0[0] + v0[1] * v0[1]) + (v0[2] * v0[2] + v0[3] * v0[3]) + (v1[0] * v1[0] + v1[1] * v1[1]) + (v1[2] * v1[2] + v1[3] * v1[3]);
                sq += __shfl_xor(sq, 16); sq += __shfl_xor(sq, 32);
                if (fq == 0) atomicAdd(ss + r, (unsigned long long)(sq * 1048576.0f + 0.5f)); }
    }
};
struct EpiWin {
    static constexpr bool PERM = true, AFTER_DRAIN = false;
    bf16_t* BG; bf16_t* CV; const unsigned long long* ss; float* convP; float* convS;
    __device__ __forceinline__ void operator()(const f32x4 (&acc)[2][2][4][2], const Unit& u, int wr, int wc, int fr, int fq) const {
        const int row0 = u.pm * BM + wr * 64 + fr;
        unsigned long long sv[2][4];
#pragma unroll
        for (int ai = 0; ai < 2; ++ai)
#pragma unroll
            for (int m = 0; m < 4; ++m) sv[ai][m] = ss[row0 + ai * HALF + m * 16];
#pragma unroll
        for (int ai = 0; ai < 2; ++ai)
#pragma unroll
            for (int m = 0; m < 4; ++m) { const int r = row0 + ai * HALF + m * 16; const float rs2 = __builtin_amdgcn_rcpf((float)sv[ai][m] * (1.0f / (1024.0f * 1048576.0f)) + RMS_EPS_);
                if (u.pn < 8) { const int c = u.pn * HALF + wc * 32 + 8 * fq;
                    f32x4 v0 = acc[ai][0][m][0] * acc[ai][1][m][0] * rs2, v1 = acc[ai][0][m][1] * acc[ai][1][m][1] * rs2;
                    u32x4 w; w.x = cvt_pk_bf16(v0[0], v0[1]); w.y = cvt_pk_bf16(v0[2], v0[3]); w.z = cvt_pk_bf16(v1[0], v1[1]); w.w = cvt_pk_bf16(v1[2], v1[3]);
                    *(u32x4*)(CV + (size_t)r * 1024 + c) = w;
                    if (r < MPR) { const int t = r & 2047; if (t >= 2046) { float* o = convP + ((size_t)(r >> 11) * 2 + (t - 2046)) * 1024 + c; *(f32x4*)o = v0; *(f32x4*)(o + 4) = v1; } }
                    else if (r < MRR) { float* o = convS + ((size_t)(r - MPR) * 2 + 1) * 1024 + c; *(f32x4*)o = v0; *(f32x4*)(o + 4) = v1; }
                } else { const float rs = __builtin_sqrtf(rs2); const int c = (u.pn - 8) * BM + wc * 32 + 8 * fq;
#pragma unroll
                    for (int bj = 0; bj < 2; ++bj) { const f32x4 v0 = acc[ai][bj][m][0] * rs, v1 = acc[ai][bj][m][1] * rs;
                        u32x4 w; w.x = cvt_pk_bf16(v0[0], v0[1]); w.y = cvt_pk_bf16(v0[2], v0[3]); w.z = cvt_pk_bf16(v1[0], v1[1]); w.w = cvt_pk_bf16(v1[2], v1[3]);
                        *(u32x4*)(BG + (size_t)r * 1024 + c + bj * HALF) = w; } } }
    }
};
template <class Epi, class Sched, bool ALIGN_EPI = false, bool SP2 = false>
__device__ __forceinline__ void gemm_phase(PG8_LAS unsigned char* lds, const Gemm g, const Sched& S, const Epi& E) {
    int tid_ = threadIdx.x; asm volatile("" : "+v"(tid_)); const int tid = tid_, wid = __builtin_amdgcn_readfirstlane(tid >> 6), lane = tid & 63, wr = wid >> 2, wc = wid & 3, fr = lane & 15, fq = lane >> 4;
    const int K = g.K, nt = K / BK;
    unsigned voffA[2], voffB[2];
#pragma unroll
    for (int i = 0; i < 2; ++i) { int R, C; stage_rc(tid * 16 + i * 8192, R, C); const int Rb = Epi::PERM ? ((R & ~31) + perm32(R & 31)) : R;
        voffA[i] = (unsigned)(R * K + C) * 2u; voffB[i] = (unsigned)(Rb * K + C) * 2u; }
    const size_t kstep = (size_t)(BK * 2);
    const size_t hstep = (size_t)HALF * K * 2;
    const size_t tstep = 2 * hstep;
    const unsigned ldsw = (unsigned)wid * 1024u;
    const int aoff = lds_byte(wr * 64 + fr, fq * 8), boff = lds_byte(wc * 32 + fr, fq * 8);
#define PG8_SA(b, h) (((b) * 2 + (h)) * HTB)
#define PG8_SB(b, h) ((4 + (b) * 2 + (h)) * HTB)
#define PG8_STAGE(bufoff, gbase, voff) do { _Pragma("unroll") for (int _i = 0; _i < 2; ++_i) \
        __builtin_amdgcn_global_load_lds((const unsigned*)((const char*)(gbase) + (voff)[_i]), (PG8_LAS unsigned*)(lds + (bufoff) + ldsw + _i * 8192), 16, 0, 0); } while (0)
#define PG8_LDA(dst, b, h) do { _Pragma("unroll") for (int m = 0; m < 4; ++m) _Pragma("unroll") for (int k = 0; k < 2; ++k) dst[m][k] = *(const PG8_LAS bf16x8*)(lds + PG8_SA(b, h) + aoff + m * 2048 + k * 1024); } while (0)
#define PG8_LDB(dst, b, h) do { _Pragma("unroll") for (int n = 0; n < 2; ++n) _Pragma("unroll") for (int k = 0; k < 2; ++k) dst[n][k] = *(const PG8_LAS bf16x8*)(lds + PG8_SB(b, h) + boff + n * 2048 + k * 1024); } while (0)
#define PG8_MMA(ai, bj, At, Bt) do { __builtin_amdgcn_s_setprio(1); _Pragma("unroll") for (int m = 0; m < 4; ++m) _Pragma("unroll") for (int n = 0; n < 2; ++n) _Pragma("unroll") for (int k = 0; k < 2; ++k) \
        acc[ai][bj][m][n] = __builtin_amdgcn_mfma_f32_16x16x32_bf16(Bt[n][k], At[m][k], acc[ai][bj][m][n], 0, 0, 0); __builtin_amdgcn_s_setprio(0); } while (0)
#define PG8_WAIT_V(n) asm volatile("s_waitcnt vmcnt(" #n ")" ::: "memory")
#define PG8_WAIT_L(n) asm volatile("s_waitcnt lgkmcnt(" #n ")" ::: "memory")
#define PG8_BAR __builtin_amdgcn_s_barrier()
#define PG8_SCHED __builtin_amdgcn_sched_barrier(0)
    Unit cur, nxt; int ui = 0;
    if (!S.next(0, cur)) return;
    f32x4 acc[2][2][4][2];
#pragma unroll
    for (int a = 0; a < 2; ++a)
#pragma unroll
        for (int b = 0; b < 2; ++b)
#pragma unroll
            for (int m = 0; m < 4; ++m)
#pragma unroll
                for (int n = 0; n < 2; ++n) acc[a][b][m][n] = (f32x4){0.f, 0.f, 0.f, 0.f};
    bf16x8 At[4][2], B0[2][2], B1[2][2];
    const char* cA = (const char*)g.A + (size_t)cur.pm * tstep; const char* cB = (const char*)g.Bt + (size_t)cur.pn * tstep;
    S.a_ready(cur);
    if constexpr (SP2) {
        PG8_STAGE(PG8_SB(0, 0), cB, voffB); PG8_STAGE(PG8_SB(0, 1), cB + hstep, voffB); PG8_STAGE(PG8_SA(0, 0), cA, voffA); PG8_STAGE(PG8_SA(0, 1), cA + hstep, voffA);
        if (wr == 1) PG8_BAR;
        PG8_WAIT_V(2); PG8_BAR;
        PG8_STAGE(PG8_SB(1, 0), cB + kstep, voffB); PG8_STAGE(PG8_SA(1, 0), cA + kstep, voffA); PG8_STAGE(PG8_SB(1, 1), cB + hstep + kstep, voffB);
        PG8_WAIT_V(6); PG8_BAR;
    } else {
        PG8_STAGE(PG8_SB(0, 0), cB, voffB); PG8_STAGE(PG8_SA(0, 0), cA, voffA); PG8_STAGE(PG8_SB(0, 1), cB + hstep, voffB); PG8_STAGE(PG8_SA(0, 1), cA + hstep, voffA);
        if (wr == 1) PG8_BAR;
        PG8_WAIT_V(4); PG8_BAR;
        PG8_STAGE(PG8_SB(1, 0), cB + kstep, voffB); PG8_STAGE(PG8_SA(1, 0), cA + kstep, voffA); PG8_STAGE(PG8_SB(1, 1), cB + hstep + kstep, voffB);
        PG8_WAIT_V(6); PG8_BAR;
    }
    for (;;) {
        const bool has_next = S.next(ui + 1, nxt);
        const char* nA = has_next ? (const char*)g.A + (size_t)nxt.pm * tstep : cA; const char* nB = has_next ? (const char*)g.Bt + (size_t)nxt.pn * tstep : cB;
        for (int t = 0; t < nt; t += 2) {
            const bool last = (t == nt - 2);
            const char* a1 = cA + (size_t)(t + 1) * kstep;
            const char* a2 = last ? nA : cA + (size_t)(t + 2) * kstep; const char* b2 = last ? nB : cB + (size_t)(t + 2) * kstep;
            const char* a3 = a2 + kstep; const char* b3 = b2 + kstep;
            if (last && has_next) S.a_ready(nxt);
            if constexpr (SP2) {
            PG8_LDB(B0, 0, 0); PG8_LDB(B1, 0, 1); PG8_SCHED; PG8_LDA(At, 0, 0); PG8_STAGE(PG8_SA(1, 1), a1 + hstep, voffA);
            PG8_WAIT_V(8); PG8_WAIT_L(0); PG8_BAR; PG8_MMA(0, 0, At, B0); PG8_MMA(0, 1, At, B1); PG8_BAR; PG8_SCHED;
            PG8_LDA(At, 0, 1); PG8_STAGE(PG8_SB(0, 0), b2, voffB); PG8_STAGE(PG8_SB(0, 1), b2 + hstep, voffB); PG8_STAGE(PG8_SA(0, 0), a2, voffA);
            PG8_WAIT_V(8); PG8_WAIT_L(0); PG8_BAR; PG8_MMA(1, 0, At, B0); PG8_MMA(1, 1, At, B1); PG8_BAR; PG8_SCHED;
            PG8_LDB(B0, 1, 0); PG8_LDB(B1, 1, 1); PG8_SCHED; PG8_LDA(At, 1, 0); PG8_STAGE(PG8_SA(0, 1), a2 + hstep, voffA);
            PG8_WAIT_V(8); PG8_WAIT_L(0); PG8_BAR; PG8_MMA(0, 0, At, B0); PG8_MMA(0, 1, At, B1); PG8_BAR; PG8_SCHED;
            PG8_LDA(At, 1, 1); PG8_STAGE(PG8_SB(1, 0), b3, voffB); PG8_STAGE(PG8_SB(1, 1), b3 + hstep, voffB); PG8_STAGE(PG8_SA(1, 0), a3, voffA);
            PG8_WAIT_V(8); PG8_WAIT_L(0); PG8_BAR; PG8_MMA(1, 0, At, B0); PG8_MMA(1, 1, At, B1); PG8_BAR; PG8_SCHED;
            } else {
            PG8_LDB(B0, 0, 0); PG8_SCHED; PG8_LDA(At, 0, 0); PG8_STAGE(PG8_SA(1, 1), a1 + hstep, voffA);
            PG8_WAIT_L(8); PG8_BAR; PG8_WAIT_L(0); PG8_MMA(0, 0, At, B0); PG8_BAR; PG8_SCHED;
            PG8_LDB(B1, 0, 1); PG8_STAGE(PG8_SB(0, 0), b2, voffB);
            PG8_BAR; PG8_WAIT_L(0); PG8_MMA(0, 1, At, B1); PG8_BAR;
            PG8_LDA(At, 0, 1); PG8_STAGE(PG8_SA(0, 0), a2, voffA);
            PG8_BAR; PG8_WAIT_L(0); PG8_MMA(1, 0, At, B0); PG8_BAR; PG8_SCHED;
            PG8_STAGE(PG8_SB(0, 1), b2 + hstep, voffB);
            PG8_WAIT_V(6); PG8_BAR; PG8_MMA(1, 1, At, B1); PG8_BAR;
            PG8_LDB(B0, 1, 0); PG8_SCHED; PG8_LDA(At, 1, 0); PG8_STAGE(PG8_SA(0, 1), a2 + hstep, voffA);
            PG8_WAIT_L(8); PG8_BAR; PG8_WAIT_L(0); PG8_MMA(0, 0, At, B0); PG8_BAR; PG8_SCHED;
            PG8_LDB(B1, 1, 1); PG8_STAGE(PG8_SB(1, 0), b3, voffB);
            PG8_BAR; PG8_WAIT_L(0); PG8_MMA(0, 1, At, B1); PG8_BAR;
            PG8_LDA(At, 1, 1); PG8_STAGE(PG8_SA(1, 0), a3, voffA);
            PG8_BAR; PG8_WAIT_L(0); PG8_MMA(1, 0, At, B0); PG8_BAR; PG8_SCHED;
            PG8_STAGE(PG8_SB(1, 1), b3 + hstep, voffB);
            PG8_WAIT_V(6); PG8_BAR; PG8_MMA(1, 1, At, B1); PG8_BAR;
            }
        }
        if constexpr (ALIGN_EPI) { if (wr == 0) PG8_BAR; }
        if constexpr (!Epi::AFTER_DRAIN) { E(acc, cur, wr, wc, fr, fq); S.done(cur); }
        if (!has_next) break;
#pragma unroll
        for (int a = 0; a < 2; ++a)
#pragma unroll
            for (int b = 0; b < 2; ++b)
#pragma unroll
                for (int m = 0; m < 4; ++m)
#pragma unroll
                    for (int n = 0; n < 2; ++n) acc[a][b][m][n] = (f32x4){0.f, 0.f, 0.f, 0.f};
        cur = nxt; cA = nA; cB = nB; ++ui;
        if constexpr (ALIGN_EPI) { if (wr == 1) PG8_BAR; }
    }
    PG8_WAIT_V(0);
    if constexpr (!ALIGN_EPI) { if (wr == 0) PG8_BAR; }
    PG8_BAR;
    if constexpr (Epi::AFTER_DRAIN) { E.fused(acc, cur, wr, wc, fr, fq, lds, wid, lane); S.done(cur); }
#undef PG8_SA
#undef PG8_SB
#undef PG8_STAGE
#undef PG8_LDA
#undef PG8_LDB
#undef PG8_MMA
#undef PG8_WAIT_V
#undef PG8_WAIT_L
#undef PG8_BAR
#undef PG8_SCHED
}
}

namespace cg = cooperative_groups;
#ifndef GEMM_SP2
#define GEMM_SP2 true
#endif
#ifndef GEMM_ALIGN
#define GEMM_ALIGN true
#endif
using pg8::bf16_t; using pg8::bf16x8; using pg8::f32x4; using pg8::u32x4; using pg8::cvt_pk_bf16;
typedef float f32x2_t __attribute__((ext_vector_type(2)));

constexpr int D = 1024, FF = 4096, MP = 16384, MS = 128, MR = 16512, MPAD = 16640, NG = 64, NP = 64, NH = 16, RCH = 1024;
constexpr int NTHR = 512;
constexpr float EPS = 1e-6f;

constexpr size_t MiB = 1024 * 1024;
__host__ __device__ constexpr size_t W_GLU(int j) { return j == 0 ? 0 : 20 * MiB; }
__host__ __device__ constexpr size_t W_UP(int i) { return i == 0 ? 4 * MiB : (24 + 8 * (size_t)(i - 1)) * MiB; }
__host__ __device__ constexpr size_t W_DOWN(int i) { return i == 0 ? 12 * MiB : (48 + 8 * (size_t)(i - 1)) * MiB; }
__host__ __device__ constexpr size_t W_IN(int j) { return (72 + 6 * (size_t)j) * MiB; }
__host__ __device__ constexpr size_t W_OUT(int j) { return (84 + 2 * (size_t)j) * MiB; }
constexpr size_t WS_XB = 88 * MiB;
constexpr size_t WS_ACT = WS_XB + (size_t)MPAD * 1024 * 2;
constexpr size_t ACT_BYTES = (size_t)MPAD * 4096 * 2;
constexpr size_t WS_SS = WS_ACT + ACT_BYTES;
constexpr size_t WS_US = WS_SS + 9 * (size_t)MPAD * 8;
constexpr size_t WS_PAR = WS_US + 4096;
constexpr size_t PAR_ABAR = 0, PAR_A16 = 32768, PAR_BB = 65536, PAR_CC = 65536 + 524288, PAR_BYTES = 65536 + 2 * 524288;
constexpr size_t WS_BAR = WS_PAR + 2 * PAR_BYTES;
constexpr size_t WS_CNT = WS_BAR + 16384;
constexpr size_t WS_END = WS_CNT + 16384;
constexpr size_t A_YACT = 0;
constexpr size_t A_WG = 40 * MiB;
constexpr size_t A_TV = 44 * MiB;
constexpr size_t A_BG = 0, A_CV = (size_t)MPAD * 1024 * 2, A_Z = 2 * (size_t)MPAD * 1024 * 2;
constexpr size_t WS_WG1 = 0, WS_TV1 = 4 * MiB;
constexpr int USTR = 528, LDS_S = 128 * USTR, LDS_TOTAL = 2 * 128 * USTR;
static_assert(LDS_TOTAL >= pg8::STAGE_BYTES, "LDS");

constexpr size_t O_Y = 0, O_REP = 16908288, O_IMP = 16973824, O_CVP = 17039360, O_RES = 17072128, O_IMS = 18120704, O_CVS = 19169280;

struct Params {
    const float* in[22];
    float* out; unsigned char* ws;
    int ph_lo, ph_hi;
};
typedef const __attribute__((address_space(4))) Params* KP;


#define XB_TMO      128
#define XB_XCNT(j)  (256  + 64 * (j))
#define XB_XSUB(j)  (1280 + 64 * (j))
#define XB_XGEN(j)  (2304 + 64 * (j))
#define XB_TOP      3328
#define XB_TOPGEN   3392
#define XCD_BAR_WORDS 3456
#define XB_SPIN_CAP (1u << 18)
#define LAS __attribute__((address_space(3)))
__device__ __forceinline__ unsigned xb_ld(unsigned* p)              { return __hip_atomic_load(p, __ATOMIC_RELAXED, __HIP_MEMORY_SCOPE_AGENT); }
__device__ __forceinline__ unsigned xb_add(unsigned* p, unsigned v) { return __hip_atomic_fetch_add(p, v, __ATOMIC_RELAXED, __HIP_MEMORY_SCOPE_AGENT); }
__device__ __forceinline__ unsigned xb_xcc_id() { return (unsigned)__builtin_amdgcn_s_getreg((3 << 11) | 20) & 0xFu; }
#define XB_SPIN(cond, bar) do { unsigned _sp = 0; while (cond) { __builtin_amdgcn_s_sleep(1); \
    if ((++_sp & 255u) == 0u) { if (xb_ld(&(bar)[XB_TMO])) break; if (_sp > XB_SPIN_CAP) { atomicAdd(&(bar)[XB_TMO], 1u); break; } } } } while (0)
struct XcdBarrier { unsigned* bar; unsigned x; volatile LAS unsigned* st; };
__device__ __forceinline__ XcdBarrier xcd_barrier_post(unsigned* bar, volatile LAS unsigned* st) {
    XcdBarrier b; b.bar = bar; b.x = xb_xcc_id(); b.st = st;
    if (threadIdx.x == 0) (void)xb_add(&bar[XB_XCNT(b.x)], 1u);
    return b;
}
__device__ __forceinline__ void xcd_barrier_complete(unsigned* bar, unsigned x, unsigned& nloc, unsigned& nx) {
    const unsigned G = gridDim.x * gridDim.y * gridDim.z;
    unsigned sum, cnt, mine, sp = 0u;
    for (;;) {
        sum = 0u; cnt = 0u; mine = 0u;
#pragma unroll
        for (unsigned j = 0; j < 16; ++j) { const unsigned c = xb_ld(&bar[XB_XCNT(j)]); sum += c; cnt += (c > 0u) ? 1u : 0u; mine = (j == x) ? c : mine; }
        if (sum == G) break;
        __builtin_amdgcn_s_sleep(1);
        if ((++sp & 255u) == 0u) { if (xb_ld(&bar[XB_TMO])) break; if (sp > XB_SPIN_CAP) { atomicAdd(&bar[XB_TMO], 1u); break; } }
    }
    nloc = mine > 0u ? mine : 1u; nx = cnt > 0u ? cnt : 1u;
}
__device__ __forceinline__ void xcd_barrier(const XcdBarrier& b) {
    asm volatile("s_waitcnt vmcnt(0)" ::: "memory");
    __syncthreads();
    if (threadIdx.x == 0) {
        unsigned* bar = b.bar;
        __builtin_amdgcn_s_waitcnt(0);
        unsigned nloc = b.st[0], nx = b.st[1];
        if (nloc == 0u) { xcd_barrier_complete(bar, b.x, nloc, nx); b.st[0] = nloc; b.st[1] = nx; }
        const unsigned old = xb_add(&bar[XB_XSUB(b.x)], 1u);
        const unsigned gen = old / nloc;
        if (old + 1u == (gen + 1u) * nloc) {
            __builtin_amdgcn_fence(__ATOMIC_RELEASE, "agent");
            asm volatile("s_waitcnt vmcnt(0)" ::: "memory");
            const unsigned og = xb_add(&bar[XB_TOP], 1u);
            const unsigned tg = og / nx;
            if (og + 1u == (tg + 1u) * nx) xb_add(&bar[XB_TOPGEN], 1u);
            else XB_SPIN(xb_ld(&bar[XB_TOPGEN]) == tg, bar);
            __builtin_amdgcn_fence(__ATOMIC_ACQUIRE, "agent");
            xb_add(&bar[XB_XGEN(b.x)], 1u);
            asm volatile("s_waitcnt vmcnt(0)" ::: "memory");
        } else {
            XB_SPIN(xb_ld(&bar[XB_XGEN(b.x)]) == gen, bar);
            __builtin_amdgcn_fence(__ATOMIC_ACQUIRE, "agent");
            asm volatile("s_waitcnt vmcnt(0)" ::: "memory");
        }
    }
    __syncthreads();
}

__device__ __forceinline__ int tid_opaque() { int t = threadIdx.x; asm volatile("" : "+v"(t)); return t; }
__device__ __forceinline__ float wave_sum(float v) {
#pragma unroll
    for (int o = 32; o >= 1; o >>= 1) v += __shfl_xor(v, o);
    return v;
}
__device__ __forceinline__ float gelu_tanh(float x) {
    const float z = 1.5957691216f * (x + 0.044715f * x * x * x);
    return x * __builtin_amdgcn_rcpf(1.0f + __expf(-z));
}

__device__ __forceinline__ int src_col(int mode, int np) {
    if (mode == 1) { const int pn = np >> 8, h = (np >> 7) & 1, i = np & 127; return h * 1024 + pn * 128 + i; }
    if (mode == 2) { const int pn = np >> 8; if (pn < 8) { const int h = (np >> 7) & 1, i = np & 127; return (1 + h) * 1024 + pn * 128 + i; } return np - 2048; }
    return np;
}
__device__ void transpose_job(const float* __restrict__ W, bf16_t* __restrict__ Bt, const float* __restrict__ scale, int K, int N, int mode, int first, int stride, int nunits, float* tl  ) {
    const int tid = tid_opaque(), nkt = K >> 6;
    const int kk0 = tid >> 4, n4 = (tid & 15) * 4;
    f32x4 v[4][2], vn[4][2];
    auto issue = [&](int unit, f32x4 (&d)[4][2]) {
#pragma unroll
        for (int q = 0; q < 4; ++q) { const int tile = unit * 4 + q, nt = tile / nkt, kt = tile - nt * nkt, k0 = kt << 6, n0 = src_col(mode, nt << 6);
#pragma unroll
            for (int it = 0; it < 2; ++it) d[q][it] = *(const f32x4*)(W + (size_t)(k0 + it * 32 + kk0) * N + n0 + n4); } };
    if (first < nunits) issue(first, v);
    for (int unit = first; unit < nunits; unit += stride) {
        const bool more = unit + stride < nunits;
        if (more) issue(unit + stride, vn);
#pragma unroll
        for (int q = 0; q < 4; ++q) { const int tile = unit * 4 + q, nt = tile / nkt, kt = tile - nt * nkt, k0 = kt << 6;
#pragma unroll
            for (int it = 0; it < 2; ++it) { const int kk = it * 32 + kk0; f32x4 x = v[q][it]; if (scale) x = x * scale[k0 + kk];
                float* t = tl + q * 4160 + kk * 65 + n4; t[0] = x[0]; t[1] = x[1]; t[2] = x[2]; t[3] = x[3]; } }
        __syncthreads();
#pragma unroll
        for (int q = 0; q < 4; ++q) { const int tile = unit * 4 + q, nt = tile / nkt, kt = tile - nt * nkt, k0 = kt << 6, np0 = nt << 6;
            const int n = tid >> 3, k8 = (tid & 7) * 8; float f[8];
#pragma unroll
            for (int j = 0; j < 8; ++j) f[j] = tl[q * 4160 + (k8 + j) * 65 + n];
            u32x4 w; w.x = cvt_pk_bf16(f[0], f[1]); w.y = cvt_pk_bf16(f[2], f[3]); w.z = cvt_pk_bf16(f[4], f[5]); w.w = cvt_pk_bf16(f[6], f[7]);
            *(u32x4*)(Bt + (size_t)(np0 + n) * K + k0 + k8) = w; }
        __syncthreads();
        if (more) {
#pragma unroll
            for (int q = 0; q < 4; ++q) { v[q][0] = vn[q][0]; v[q][1] = vn[q][1]; } }
    }
}

__device__ void ssm_gen_unit(KP p, int j, int part, unsigned char* lds, bf16_t* WGm, bf16_t* TVm, unsigned char* par) {
    f32x2_t* apow = (f32x2_t*)lds;
    f32x2_t* Bb = apow + 17 * 64;
    f32x2_t* Cc = Bb + 1024;
    float* Kt = (float*)(Cc + 1024);
    f32x2_t* qf = (f32x2_t*)(Kt + 4096);
    const int tid = tid_opaque(), g = part >> 2, q = part & 3;
    const float* a_re = p->in[8] + (size_t)(j * NG + g) * NP; const float* a_im = p->in[9] + (size_t)(j * NG + g) * NP;
    const float dt = expf(p->in[10][j * NG + g]);
    for (int idx = tid; idx < 17 * 64 + 64; idx += NTHR) {
        if (idx < 17 * 64) { const int tau = idx >> 6, pp = idx & 63; const float x = (float)tau * dt * a_re[pp], y = (float)tau * dt * a_im[pp]; float s, c; sincosf(y, &s, &c); const float e = expf(x);
            const f32x2_t v = (f32x2_t){e * c, e * s}; apow[idx] = v;
            if (q == 0 && tau == 1) ((f32x2_t*)(par + PAR_ABAR))[g * 64 + pp] = v;
            if (q == 0 && tau == 16) ((f32x2_t*)(par + PAR_A16))[g * 64 + pp] = v; }
        else { const int pp = idx - 17 * 64; const float ar = a_re[pp], ai = a_im[pp]; const float x = dt * ar, y = dt * ai; float s, c, sh, ch; sincosf(y, &s, &c); sincosf(0.5f * y, &sh, &ch);
            const float er = expm1f(x) * c - 2.0f * sh * sh, ei = expf(x) * s;
            const float den = 1.0f / (ar * ar + ai * ai); qf[pp] = (f32x2_t){(er * ar + ei * ai) * den, (ei * ar - er * ai) * den}; } }
    for (int i = tid; i < 1024; i += NTHR) { const size_t ci = (size_t)(j * NG + g) * 1024 + i; const f32x2_t cc = (f32x2_t){p->in[13][ci], p->in[14][ci]};
        Cc[i] = cc; if (q == 0) ((f32x2_t*)(par + PAR_CC))[(size_t)g * 1024 + i] = cc; }
    __syncthreads();
    for (int i = tid; i < 1024; i += NTHR) { const int pp = i >> 4, h = i & 15; const f32x2_t qq = qf[pp];
        const size_t bi = ((size_t)(j * NG + g) * NP + pp) * NH + h; const float br = p->in[11][bi], bim = p->in[12][bi];
        const f32x2_t bb = (f32x2_t){qq.x * br - qq.y * bim, qq.x * bim + qq.y * br};
        Bb[pp * 16 + h] = bb; if (q == 0) ((f32x2_t*)(par + PAR_BB))[((size_t)g * NH + h) * NP + pp] = bb; }
    __syncthreads();
    for (int i2 = tid; i2 < 1024; i2 += NTHR) { const int tau = i2 >> 6, ho = 4 * q + ((i2 >> 4) & 3), hi = i2 & 15; float acc = 0.f;
        for (int pp = 0; pp < 64; ++pp) { const f32x2_t c = Cc[ho * 64 + pp], a = apow[tau * 64 + pp], b = Bb[pp * 16 + hi];
            const float car = c.x * a.x - c.y * a.y, cai = c.x * a.y + c.y * a.x; acc += car * b.x - cai * b.y; }
        if (tau == 0 && ho == hi) acc += p->in[15][j * D + g * 16 + ho];
        Kt[(tau * 16 + ho) * 16 + hi] = acc; }
    __syncthreads();
    bf16_t* TV = TVm + (size_t)g * 256 * 384;
    for (int it = tid; it < 1024; it += NTHR) { const int s = it & 15, ho = 4 * q + ((it >> 4) & 3), t = it >> 6, n = t * 16 + ho; float f[16];
#pragma unroll
        for (int hi = 0; hi < 16; ++hi) f[hi] = (s <= t) ? Kt[((t - s) * 16 + ho) * 16 + hi] : 0.f;
        u32x4 w0, w1; w0.x = cvt_pk_bf16(f[0], f[1]); w0.y = cvt_pk_bf16(f[2], f[3]); w0.z = cvt_pk_bf16(f[4], f[5]); w0.w = cvt_pk_bf16(f[6], f[7]);
        w1.x = cvt_pk_bf16(f[8], f[9]); w1.y = cvt_pk_bf16(f[10], f[11]); w1.z = cvt_pk_bf16(f[12], f[13]); w1.w = cvt_pk_bf16(f[14], f[15]);
        u32x4* o = (u32x4*)(TV + (size_t)n * 384 + s * 16); o[0] = w0; o[1] = w1; }
    for (int it = tid; it < 1024; it += NTHR) { const int p4 = (it & 15) * 4, ho = 4 * q + ((it >> 4) & 3), t = it >> 6, n = t * 16 + ho; float f[8];
#pragma unroll
        for (int r = 0; r < 4; ++r) { const f32x2_t c = Cc[ho * 64 + p4 + r], a = apow[(t + 1) * 64 + p4 + r]; f[2 * r] = c.x * a.x - c.y * a.y; f[2 * r + 1] = -(c.x * a.y + c.y * a.x); }
        u32x4 w; w.x = cvt_pk_bf16(f[0], f[1]); w.y = cvt_pk_bf16(f[2], f[3]); w.z = cvt_pk_bf16(f[4], f[5]); w.w = cvt_pk_bf16(f[6], f[7]);
        *(u32x4*)(TV + (size_t)n * 384 + 256 + 2 * p4) = w; }
    bf16_t* WG = WGm + (size_t)g * 128 * 256;
    { const int n = 32 * q + (tid >> 4), s = tid & 15, pp = n >> 1, c = n & 1; const f32x2_t a = apow[(15 - s) * 64 + pp]; float f[16];
#pragma unroll
        for (int hi = 0; hi < 16; ++hi) { const f32x2_t b = Bb[pp * 16 + hi]; f[hi] = c ? (a.x * b.y + a.y * b.x) : (a.x * b.x - a.y * b.y); }
        u32x4 w0, w1; w0.x = cvt_pk_bf16(f[0], f[1]); w0.y = cvt_pk_bf16(f[2], f[3]); w0.z = cvt_pk_bf16(f[4], f[5]); w0.w = cvt_pk_bf16(f[6], f[7]);
        w1.x = cvt_pk_bf16(f[8], f[9]); w1.y = cvt_pk_bf16(f[10], f[11]); w1.z = cvt_pk_bf16(f[12], f[13]); w1.w = cvt_pk_bf16(f[14], f[15]);
        u32x4* o = (u32x4*)(WG + (size_t)n * 256 + s * 16); o[0] = w0; o[1] = w1; }
    __syncthreads();
}

__device__ void rowss_unit(KP p, int unit, unsigned char* lds) {
    const int tid = tid_opaque(), w = tid >> 6, lane = tid & 63;
    unsigned long long* ss = (unsigned long long*)(p->ws + WS_SS) + 8 * (size_t)MPAD;
    bf16_t* tile = (bf16_t*)lds;
    f32x4 v[2][4];
#pragma unroll
    for (int tt = 0; tt < 2; ++tt) { const int r = unit * 16 + w * 2 + tt; const float* row = (r < MP) ? p->in[0] + (size_t)r * D : p->in[1] + (size_t)(r - MP) * D;
#pragma unroll
        for (int q = 0; q < 4; ++q) v[tt][q] = *(const f32x4*)(row + lane * 16 + q * 4); }
#pragma unroll
    for (int tt = 0; tt < 2; ++tt) { float sq = 0.f;
#pragma unroll
        for (int q = 0; q < 4; ++q) sq += (v[tt][q][0] * v[tt][q][0] + v[tt][q][1] * v[tt][q][1]) + (v[tt][q][2] * v[tt][q][2] + v[tt][q][3] * v[tt][q][3]);
        sq = wave_sum(sq);
        if (lane == 0) ss[unit * 16 + w * 2 + tt] = (unsigned long long)(sq * 1048576.0f + 0.5f);
        u32x4 w0, w1; w0.x = cvt_pk_bf16(v[tt][0][0], v[tt][0][1]); w0.y = cvt_pk_bf16(v[tt][0][2], v[tt][0][3]); w0.z = cvt_pk_bf16(v[tt][1][0], v[tt][1][1]); w0.w = cvt_pk_bf16(v[tt][1][2], v[tt][1][3]);
        w1.x = cvt_pk_bf16(v[tt][2][0], v[tt][2][1]); w1.y = cvt_pk_bf16(v[tt][2][2], v[tt][2][3]); w1.z = cvt_pk_bf16(v[tt][3][0], v[tt][3][1]); w1.w = cvt_pk_bf16(v[tt][3][2], v[tt][3][3]);
        u32x4* o = (u32x4*)(tile + (w * 2 + tt) * 1024 + lane * 16); o[0] = w0; o[1] = w1; }
    if (unit * 16 < MP) {
        __syncthreads();
        bf16_t* XG = (bf16_t*)(p->ws + WS_XB);
#pragma unroll
        for (int i = 0; i < 4; ++i) { const int idx = i * NTHR + tid, g = idx >> 5, q = idx & 31, t = q >> 1, half = q & 1;
            const u32x4 x = *(const u32x4*)(tile + t * 1024 + g * 16 + half * 8);
            *(u32x4*)(XG + ((size_t)g * MPAD + unit * 16) * 16 + q * 8) = x; }
        __syncthreads(); }
}

__device__ void s5_unit(KP p, int j, int g, int b0, const bf16_t* WGm, const bf16_t* TVm, const unsigned char* par, const bf16_t* XG, const unsigned long long* ssrc, const float* gain, unsigned char* lds) {
    const int tid = tid_opaque(), w = __builtin_amdgcn_readfirstlane(tid >> 6), lane = tid & 63, fr = lane & 15, fq = lane >> 4;
    const bf16_t* WG = WGm + (size_t)g * 128 * 256; const bf16_t* TV = TVm + (size_t)g * 256 * 384;
    const float SSC = 1.0f / (1024.0f * 1048576.0f);
    const int t0 = w, t1 = 15 - w, kmax0 = t0 >> 1, kmax1 = t1 >> 1;
    bf16x8 tf0[12], tf1[12];
#pragma unroll
    for (int ks = 0; ks < 12; ++ks) { tf0[ks] = *(const bf16x8*)(TV + (size_t)(t0 * 16 + fr) * 384 + ks * 32 + fq * 8); tf1[ks] = *(const bf16x8*)(TV + (size_t)(t1 * 16 + fr) * 384 + ks * 32 + fq * 8); }
  for (int b = b0; b < b0 + 2; ++b) {
    float* rt = (float*)(lds + LDS_S);
#pragma unroll
    for (int i = 0; i < 4; ++i) { const int tok = i * NTHR + tid; rt[tok] = rsqrtf((float)ssrc[b * 2048 + tok] * SSC + EPS); }
    u32x4 xv[8];
    { const bf16_t* xs = XG + ((size_t)g * MPAD + (size_t)b * 2048) * 16;
#pragma unroll
      for (int i = 0; i < 8; ++i) xv[i] = *(const u32x4*)(xs + (size_t)(i * NTHR + tid) * 8); }
    const f32x4 gv0 = *(const f32x4*)(gain + g * 16 + (tid & 1) * 8), gv1 = *(const f32x4*)(gain + g * 16 + (tid & 1) * 8 + 4);
    __syncthreads();
#pragma unroll
    for (int i = 0; i < 8; ++i) { const int idx = i * NTHR + tid, tok = idx >> 1, half = idx & 1; const float r = rt[tok]; const u32x4 x = xv[i];
        f32x4 a, c; a[0] = __uint_as_float(x.x << 16); a[1] = __uint_as_float(x.x & 0xffff0000u); a[2] = __uint_as_float(x.y << 16); a[3] = __uint_as_float(x.y & 0xffff0000u);
        c[0] = __uint_as_float(x.z << 16); c[1] = __uint_as_float(x.z & 0xffff0000u); c[2] = __uint_as_float(x.w << 16); c[3] = __uint_as_float(x.w & 0xffff0000u);
        a = a * r * gv0; c = c * r * gv1;
        u32x4 o; o.x = cvt_pk_bf16(a[0], a[1]); o.y = cvt_pk_bf16(a[2], a[3]); o.z = cvt_pk_bf16(c[0], c[1]); o.w = cvt_pk_bf16(c[2], c[3]);
        *(u32x4*)(lds + (tok >> 4) * USTR + ((tok & 15) * 16 + half * 8) * 2) = o; }
    bf16x8 wfr[8];
#pragma unroll
    for (int ks = 0; ks < 8; ++ks) wfr[ks] = *(const bf16x8*)(WG + (size_t)(w * 16 + fr) * 256 + ks * 32 + fq * 8);
    __syncthreads();
#pragma unroll 1
    for (int rb = 0; rb < 8; ++rb) { const unsigned char* arow = lds + (rb * 16 + fr) * USTR + fq * 16;
        f32x4 acc = (f32x4){0.f, 0.f, 0.f, 0.f};
#pragma unroll
        for (int ks = 0; ks < 8; ++ks) acc = __builtin_amdgcn_mfma_f32_16x16x32_bf16(wfr[ks], *(const bf16x8*)(arow + ks * 64), acc, 0, 0, 0);
        *(f32x4*)(lds + LDS_S + (rb * 16 + fr) * USTR + (16 * w + 4 * fq) * 4) = acc; }
    __syncthreads();
    {
        const f32x2_t a16 = ((const f32x2_t*)(par + PAR_A16))[g * 64 + lane];
        f32x2_t* tot = (f32x2_t*)(lds + LDS_TOTAL + 16);
        f32x2_t sv[16];
#pragma unroll
        for (int i = 0; i < 16; ++i) sv[i] = *(const f32x2_t*)(lds + LDS_S + (16 * w + i) * USTR + lane * 8);
        float lr = 0.f, li = 0.f, er[16], ei[16];
#pragma unroll
        for (int i = 0; i < 16; ++i) { er[i] = lr; ei[i] = li; const float nr = a16.x * lr - a16.y * li + sv[i].x, ni = a16.x * li + a16.y * lr + sv[i].y; lr = nr; li = ni; }
        tot[w * 64 + lane] = (f32x2_t){lr, li};
        float qr = a16.x, qi = a16.y;
#pragma unroll
        for (int t = 0; t < 4; ++t) { const float nr = qr * qr - qi * qi, ni = 2.0f * qr * qi; qr = nr; qi = ni; }
        __syncthreads();
        float gr = 0.f, gi = 0.f;
        for (int v = 0; v < w; ++v) { const f32x2_t tv = tot[v * 64 + lane]; const float nr = qr * gr - qi * gi + tv.x, ni = qr * gi + qi * gr + tv.y; gr = nr; gi = ni; }
        float pr = 1.f, pi = 0.f;
#pragma unroll
        for (int i = 0; i < 16; ++i) { const float hr = pr * gr - pi * gi + er[i], hi = pr * gi + pi * gr + ei[i];
            *(unsigned*)(lds + LDS_S + (16 * w + i) * USTR + lane * 4) = cvt_pk_bf16(hr, hi);
            const float nr = pr * a16.x - pi * a16.y, ni = pr * a16.y + pi * a16.x; pr = nr; pi = ni; }
        if (w == 7) { const float hr = pr * gr - pi * gi + lr, hi = pr * gi + pi * gr + li;
            const size_t oi = (((size_t)j * 8 + b) * NG + g) * NP + lane;
            p->out[O_REP + oi] = hr; p->out[O_IMP + oi] = hi; }
    }
    __syncthreads();
    bf16_t* Y = (bf16_t*)(p->ws + WS_ACT + A_YACT);
    f32x4 p0 = (f32x4){0.f, 0.f, 0.f, 0.f}, p1 = p0;
#pragma unroll 1
    for (int rb = 0; rb <= 8; ++rb) {
        f32x4 acc0 = (f32x4){0.f, 0.f, 0.f, 0.f}, acc1 = acc0;
        if (rb < 8) { const int c = rb * 16 + fr; const unsigned char* arow = lds + c * USTR + fq * 16; const unsigned char* hrow = lds + LDS_S + c * USTR + fq * 16;
#pragma unroll
            for (int ks = 0; ks < 8; ++ks) { if (ks <= kmax1) { const bf16x8 a = *(const bf16x8*)(arow + ks * 64);
                    acc1 = __builtin_amdgcn_mfma_f32_16x16x32_bf16(tf1[ks], a, acc1, 0, 0, 0);
                    if (ks <= kmax0) acc0 = __builtin_amdgcn_mfma_f32_16x16x32_bf16(tf0[ks], a, acc0, 0, 0, 0); } }
#pragma unroll
            for (int ks = 0; ks < 4; ++ks) { const bf16x8 a = *(const bf16x8*)(hrow + ks * 64);
                acc0 = __builtin_amdgcn_mfma_f32_16x16x32_bf16(tf0[8 + ks], a, acc0, 0, 0, 0); acc1 = __builtin_amdgcn_mfma_f32_16x16x32_bf16(tf1[8 + ks], a, acc1, 0, 0, 0); } }
        if (rb > 0) { const int c = (rb - 1) * 16 + fr;
            pg8::u32x2 w0, w1; w0.x = cvt_pk_bf16(gelu_tanh(p0[0]), gelu_tanh(p0[1])); w0.y = cvt_pk_bf16(gelu_tanh(p0[2]), gelu_tanh(p0[3]));
            w1.x = cvt_pk_bf16(gelu_tanh(p1[0]), gelu_tanh(p1[1])); w1.y = cvt_pk_bf16(gelu_tanh(p1[2]), gelu_tanh(p1[3]));
            const size_t tokb = (size_t)b * 2048 + (size_t)c * 16;
            *(pg8::u32x2*)(Y + (tokb + t0) * D + g * 16 + fq * 4) = w0;
            *(pg8::u32x2*)(Y + (tokb + t1) * D + g * 16 + fq * 4) = w1; }
        p0 = acc0; p1 = acc1; }
    __syncthreads();
  }
}
__device__ void s5_sample_wg(KP p, int j, int wgu, const unsigned char* par, const float* srcS, const unsigned long long* ssrcS, const float* gain) {
    const int tid = tid_opaque(), w = tid >> 6, lane = tid & 63, i0 = wgu >> 3, g = (wgu & 7) * 8 + w;
    f32x4 uq[4][4]; unsigned long long ssv[4]; float h0r[4], h0i[4];
#pragma unroll
    for (int s = 0; s < 4; ++s) { const int i = i0 + 32 * s; const float* u = srcS + (size_t)i * D + g * 16;
#pragma unroll
        for (int q = 0; q < 4; ++q) uq[s][q] = *(const f32x4*)(u + q * 4);
        ssv[s] = ssrcS[i]; const size_t si = (((size_t)j * MS + i) * NG + g) * NP + lane; h0r[s] = p->in[2][si]; h0i[s] = p->in[3][si]; }
    f32x4 gq[4];
#pragma unroll
    for (int q = 0; q < 4; ++q) gq[q] = *(const f32x4*)(gain + g * 16 + q * 4);
    const f32x2_t a = ((const f32x2_t*)(par + PAR_ABAR))[g * 64 + lane];
    f32x2_t Bb[16], Cc[16];
#pragma unroll
    for (int h = 0; h < 16; ++h) { Bb[h] = ((const f32x2_t*)(par + PAR_BB))[((size_t)g * NH + h) * NP + lane]; Cc[h] = ((const f32x2_t*)(par + PAR_CC))[(size_t)g * 1024 + h * 64 + lane]; }
    const float d = (lane < 16) ? p->in[15][j * D + g * 16 + lane] : 0.f;
#pragma unroll
    for (int s = 0; s < 4; ++s) { const int i = i0 + 32 * s;
        const float rstd = rsqrtf((float)ssv[s] * (1.0f / (1024.0f * 1048576.0f)) + EPS);
        float uv[16];
#pragma unroll
        for (int q = 0; q < 4; ++q) { const f32x4 t = uq[s][q] * rstd * gq[q]; uv[4 * q] = t[0]; uv[4 * q + 1] = t[1]; uv[4 * q + 2] = t[2]; uv[4 * q + 3] = t[3]; }
        float hr = a.x * h0r[s] - a.y * h0i[s], hi = a.x * h0i[s] + a.y * h0r[s];
#pragma unroll
        for (int h = 0; h < 16; ++h) { hr += Bb[h].x * uv[h]; hi += Bb[h].y * uv[h]; }
        const size_t si = (((size_t)j * MS + i) * NG + g) * NP + lane;
        p->out[O_RES + si] = hr; p->out[O_IMS + si] = hi;
        float y = 0.f;
#pragma unroll
        for (int ho = 0; ho < 16; ++ho) { const float sm = wave_sum(Cc[ho].x * hr - Cc[ho].y * hi); if (lane == ho) y = sm; }
        if (lane < 16) { float ul = 0.f;
#pragma unroll
            for (int h = 0; h < 16; ++h) ul = (lane == h) ? uv[h] : ul;
            const float v = gelu_tanh(y + d * ul);
            bf16_t* Y = (bf16_t*)(p->ws + WS_ACT + A_YACT) + (size_t)(MP + i) * D + g * 16 + lane;
            *Y = (bf16_t)(cvt_pk_bf16(v, 0.f) & 0xffffu); } }
}

enum { SK_UP = 0, SK_RES = 1, SK_GLU = 2, SK_WIN = 3 };
struct SkArgs { const bf16_t* A; const bf16_t* Bt; int K;
    bf16_t* O;
    const float* baseS; float* X; bf16_t* XB; unsigned long long* ssw;
    const unsigned long long* ssr;
    bf16_t* BG; bf16_t* CV; float* convS; };
template <int MODE>
__device__ __forceinline__ int sk2_brow(int cg, int cb, int i) {
    if (MODE == SK_UP) return 128 * cg + 16 * cb + i;
    if (MODE == SK_RES) return 32 * cg + 16 * cb + i;
    const int sel = cb >> 1, c = 32 * cg + 16 * (cb & 1) + i;
    if (MODE == SK_GLU) return 256 * (c >> 7) + 128 * sel + (c & 127);
    return sel < 2 ? 256 * (c >> 7) + 128 * sel + (c & 127) : 2048 + c;
}
template <int MODE>
__device__ void skinny2d(const SkArgs& a, int b, unsigned char* lds) {
    constexpr int NCB = MODE == SK_UP ? 8 : MODE == SK_RES ? 2 : MODE == SK_GLU ? 4 : 6, NV = MODE == SK_UP ? 8 : 2, K = 1024;
    const int tid = tid_opaque(), w = __builtin_amdgcn_readfirstlane(tid >> 6), lane = tid & 63, fr = lane & 15, fq = lane >> 4;
    const int rb = b & 7, cg = b >> 3, ecb = tid >> 6, erow = 16 * rb + fr;
    const bool red = tid < NV * 64;
    f32x4 basev = (f32x4){0.f, 0.f, 0.f, 0.f}; unsigned long long ssv = 0ull;
    if (red) { if (MODE == SK_RES || MODE == SK_GLU) basev = *(const f32x4*)(a.baseS + (size_t)erow * 1024 + 32 * cg + 16 * ecb + 4 * fq); else ssv = a.ssr[erow]; }
    const bf16_t* ap = a.A + (size_t)erow * K + 128 * w + fq * 8;
    bf16x8 av[4], bv[NCB][4];
#pragma unroll
    for (int u = 0; u < 4; ++u) av[u] = *(const bf16x8*)(ap + u * 32);
#pragma unroll
    for (int cb = 0; cb < NCB; ++cb) { const bf16_t* bp = a.Bt + (size_t)sk2_brow<MODE>(cg, cb, fr) * K + 128 * w + fq * 8;
#pragma unroll
        for (int u = 0; u < 4; ++u) bv[cb][u] = *(const bf16x8*)(bp + u * 32); }
    f32x4* part = (f32x4*)lds;
#pragma unroll
    for (int cb = 0; cb < NCB; ++cb) { f32x4 acc = (f32x4){0.f, 0.f, 0.f, 0.f};
#pragma unroll
        for (int u = 0; u < 4; ++u) acc = __builtin_amdgcn_mfma_f32_16x16x32_bf16(bv[cb][u], av[u], acc, 0, 0, 0);
        part[(w * NCB + cb) * 64 + lane] = acc; }
    __syncthreads();
    if (red) {
        const float SSC = 1.0f / (1024.0f * 1048576.0f);
        f32x4 s0 = part[ecb * 64 + lane];
#pragma unroll
        for (int v = 1; v < 8; ++v) s0 = s0 + part[(v * NCB + ecb) * 64 + lane];
        if (MODE == SK_UP) {
            const float rs2 = __builtin_amdgcn_rcpf((float)ssv * SSC + EPS);
            float h[4];
#pragma unroll
            for (int j = 0; j < 4; ++j) { const float t = fmaxf(s0[j], 0.f); h[j] = t * t * rs2; }
            pg8::u32x2 o; o.x = cvt_pk_bf16(h[0], h[1]); o.y = cvt_pk_bf16(h[2], h[3]);
            *(pg8::u32x2*)(a.O + (size_t)erow * 4096 + 128 * cg + 16 * ecb + 4 * fq) = o;
        } else if (MODE == SK_RES || MODE == SK_GLU) {
            f32x4 val = s0;
            if (MODE == SK_GLU) { f32x4 s1 = part[(2 + ecb) * 64 + lane];
#pragma unroll
                for (int v = 1; v < 8; ++v) s1 = s1 + part[(v * NCB + 2 + ecb) * 64 + lane];
#pragma unroll
                for (int j = 0; j < 4; ++j) val[j] = s0[j] * __builtin_amdgcn_rcpf(1.0f + __expf(-s1[j])); }
            const f32x4 x = val + basev; const size_t o = (size_t)erow * 1024 + 32 * cg + 16 * ecb + 4 * fq;
            *(f32x4*)(a.X + o) = x;
            if (a.XB) { pg8::u32x2 w2; w2.x = cvt_pk_bf16(x[0], x[1]); w2.y = cvt_pk_bf16(x[2], x[3]); *(pg8::u32x2*)(a.XB + o) = w2; }
            float sq = (x[0] * x[0] + x[1] * x[1]) + (x[2] * x[2] + x[3] * x[3]);
            sq += __shfl_xor(sq, 16); sq += __shfl_xor(sq, 32);
            if (fq == 0) atomicAdd(a.ssw + erow, (unsigned long long)(sq * 1048576.0f + 0.5f));
        } else {
            f32x4 s1 = part[(2 + ecb) * 64 + lane], s2 = part[(4 + ecb) * 64 + lane];
#pragma unroll
            for (int v = 1; v < 8; ++v) { s1 = s1 + part[(v * NCB + 2 + ecb) * 64 + lane]; s2 = s2 + part[(v * NCB + 4 + ecb) * 64 + lane]; }
            const float rs2 = __builtin_amdgcn_rcpf((float)ssv * SSC + EPS);
            const size_t o = (size_t)erow * 1024 + 32 * cg + 16 * ecb + 4 * fq;
            const f32x4 cv = s0 * s1 * rs2, bg = s2 * __builtin_sqrtf(rs2);
            pg8::u32x2 w2; w2.x = cvt_pk_bf16(cv[0], cv[1]); w2.y = cvt_pk_bf16(cv[2], cv[3]);
            *(pg8::u32x2*)(a.CV + o) = w2;
            *(f32x4*)(a.convS + ((size_t)erow * 2 + 1) * 1024 + 32 * cg + 16 * ecb + 4 * fq) = cv;
            pg8::u32x2 w3; w3.x = cvt_pk_bf16(bg[0], bg[1]); w3.y = cvt_pk_bf16(bg[2], bg[3]);
            *(pg8::u32x2*)(a.BG + o) = w3;
        }
    }
    __syncthreads();
}
__device__ void skinny_down2d(const SkArgs& a, int b, unsigned char* lds) {
    const int tid = tid_opaque(), w = __builtin_amdgcn_readfirstlane(tid >> 6), lane = tid & 63, fr = lane & 15, fq = lane >> 4;
    constexpr int K = 4096;
    const int rb = b & 7, cg = b >> 3;
    const bf16_t* ap = a.A + (size_t)(16 * rb + fr) * K + 512 * w + fq * 8;
    const bf16_t* bp0 = a.Bt + (size_t)(32 * cg + fr) * K + 512 * w + fq * 8;
    const bf16_t* bp1 = bp0 + (size_t)16 * K;
    const int ecb = tid >> 6, erow = 16 * rb + fr, ecol = 32 * cg + 16 * ecb + 4 * fq;
    f32x4 basev = (f32x4){0.f, 0.f, 0.f, 0.f};
    if (tid < 128) basev = *(const f32x4*)(a.baseS + (size_t)erow * 1024 + ecol);
    f32x4 acc0 = (f32x4){0.f, 0.f, 0.f, 0.f}, acc1 = acc0;
#pragma unroll
    for (int h = 0; h < 2; ++h) {
        bf16x8 av[8], b0[8], b1[8];
#pragma unroll
        for (int u = 0; u < 8; ++u) { av[u] = *(const bf16x8*)(ap + (h * 8 + u) * 32); b0[u] = *(const bf16x8*)(bp0 + (h * 8 + u) * 32); b1[u] = *(const bf16x8*)(bp1 + (h * 8 + u) * 32); }
#pragma unroll
        for (int u = 0; u < 8; ++u) { acc0 = __builtin_amdgcn_mfma_f32_16x16x32_bf16(b0[u], av[u], acc0, 0, 0, 0); acc1 = __builtin_amdgcn_mfma_f32_16x16x32_bf16(b1[u], av[u], acc1, 0, 0, 0); }
    }
    f32x4* part = (f32x4*)lds;
    part[(w * 2 + 0) * 64 + lane] = acc0; part[(w * 2 + 1) * 64 + lane] = acc1;
    __syncthreads();
    if (tid < 128) {
        f32x4 s = part[(0 * 2 + ecb) * 64 + lane];
#pragma unroll
        for (int v = 1; v < 8; ++v) s = s + part[(v * 2 + ecb) * 64 + lane];
        const f32x4 x = s + basev; const size_t o = (size_t)erow * 1024 + ecol;
        *(f32x4*)(a.X + o) = x;
        if (a.XB) { pg8::u32x2 w2; w2.x = cvt_pk_bf16(x[0], x[1]); w2.y = cvt_pk_bf16(x[2], x[3]); *(pg8::u32x2*)(a.XB + o) = w2; }
        float sq = (x[0] * x[0] + x[1] * x[1]) + (x[2] * x[2] + x[3] * x[3]);
        sq += __shfl_xor(sq, 16); sq += __shfl_xor(sq, 32);
        if (fq == 0) atomicAdd(a.ssw + erow, (unsigned long long)(sq * 1048576.0f + 0.5f));
    }
    __syncthreads();
}
__device__ __forceinline__ void unpack8(const u32x4 v, float* f) { f[0] = __uint_as_float(v.x << 16); f[1] = __uint_as_float(v.x & 0xffff0000u); f[2] = __uint_as_float(v.y << 16); f[3] = __uint_as_float(v.y & 0xffff0000u);
    f[4] = __uint_as_float(v.z << 16); f[5] = __uint_as_float(v.z & 0xffff0000u); f[6] = __uint_as_float(v.w << 16); f[7] = __uint_as_float(v.w & 0xffff0000u); }
__device__ void convgate_wg(KP p, int j, int wg) {
    const int tid = tid_opaque(), c = (tid & 127) * 8, strip = tid >> 7;
    const bf16_t* BG = (const bf16_t*)(p->ws + WS_ACT + A_BG); const bf16_t* CV = (const bf16_t*)(p->ws + WS_ACT + A_CV); bf16_t* Z = (bf16_t*)(p->ws + WS_ACT + A_Z);
    const float* cw = p->in[18] + (size_t)j * 3 * D + c;
    float w0[8], w1[8], w2[8];
#pragma unroll
    for (int q = 0; q < 8; ++q) { w0[q] = cw[q]; w1[q] = cw[D + q]; w2[q] = cw[2 * D + q]; }
    const int r0 = wg * 64 + strip * 16;
    float x0[8], x1[8];
    if ((r0 & 2047) != 0) { unpack8(*(const u32x4*)(CV + (size_t)(r0 - 2) * D + c), x0); unpack8(*(const u32x4*)(CV + (size_t)(r0 - 1) * D + c), x1); }
    else {
#pragma unroll
        for (int q = 0; q < 8; ++q) { x0[q] = 0.f; x1[q] = 0.f; } }
#pragma unroll
    for (int h = 0; h < 2; ++h) { u32x4 cv[8], bg[8];
#pragma unroll
        for (int i = 0; i < 8; ++i) { const size_t o = (size_t)(r0 + h * 8 + i) * D + c; cv[i] = *(const u32x4*)(CV + o); bg[i] = *(const u32x4*)(BG + o); }
#pragma unroll
        for (int i = 0; i < 8; ++i) { float x2[8], b[8], z[8]; unpack8(cv[i], x2); unpack8(bg[i], b);
#pragma unroll
            for (int q = 0; q < 8; ++q) { z[q] = b[q] * (w0[q] * x0[q] + w1[q] * x1[q] + w2[q] * x2[q]); x0[q] = x1[q]; x1[q] = x2[q]; }
            u32x4 w; w.x = cvt_pk_bf16(z[0], z[1]); w.y = cvt_pk_bf16(z[2], z[3]); w.z = cvt_pk_bf16(z[4], z[5]); w.w = cvt_pk_bf16(z[6], z[7]);
            *(u32x4*)(Z + (size_t)(r0 + h * 8 + i) * D + c) = w; } }
    if (wg < MS && strip == 0) { const int i = wg; const size_t r = (size_t)MP + i;
        const float* sb = p->in[4] + (((size_t)j * MS + i) * 2) * D + c; float* so = p->out + O_CVS + (((size_t)j * MS + i) * 2) * D + c;
        float x2[8], b[8], z[8]; unpack8(*(const u32x4*)(CV + r * D + c), x2); unpack8(*(const u32x4*)(BG + r * D + c), b);
#pragma unroll
        for (int q = 0; q < 8; ++q) { const float s0 = sb[q], s1 = sb[D + q]; so[q] = s1; z[q] = b[q] * (w0[q] * s0 + w1[q] * s1 + w2[q] * x2[q]); }
        u32x4 w; w.x = cvt_pk_bf16(z[0], z[1]); w.y = cvt_pk_bf16(z[2], z[3]); w.z = cvt_pk_bf16(z[4], z[5]); w.w = cvt_pk_bf16(z[6], z[7]);
        *(u32x4*)(Z + r * D + c) = w; }
}
__device__ void final_unit16(KP p, int unit) {
    const int tid = tid_opaque(), c = (tid & 127) * 8;
    const unsigned long long* ss = (const unsigned long long*)(p->ws + WS_SS) + 7 * (size_t)MPAD;
    const float* g = p->in[7] + c; const f32x4 g0 = *(const f32x4*)g, g1 = *(const f32x4*)(g + 4);
    f32x4 v0[4], v1[4]; float rstd[4];
#pragma unroll
    for (int i = 0; i < 4; ++i) { const int r = unit * 16 + i * 4 + (tid >> 7); const float* x = p->out + (size_t)r * D + c; v0[i] = *(const f32x4*)x; v1[i] = *(const f32x4*)(x + 4);
        rstd[i] = rsqrtf((float)ss[r] * (1.0f / (1024.0f * 1048576.0f)) + EPS); }
#pragma unroll
    for (int i = 0; i < 4; ++i) { const int r = unit * 16 + i * 4 + (tid >> 7); float* x = p->out + (size_t)r * D + c;
        *(f32x4*)x = v0[i] * rstd[i] * g0; *(f32x4*)(x + 4) = v1[i] * rstd[i] * g1; }
}

__device__ void decode_final_tail(KP p, int b, unsigned* cnt) {
    const int tid = tid_opaque(), lane = tid & 63, fr = lane & 15, fq = lane >> 4;
    if (tid == 0) { unsigned sp = 0; while (__hip_atomic_load(cnt, __ATOMIC_RELAXED, __HIP_MEMORY_SCOPE_AGENT) < 256u) { __builtin_amdgcn_s_sleep(2); if (++sp > (1u << 22)) break; } }
    __syncthreads();
    if (tid < 128) { const int rb = b & 7, cg = b >> 3, erow = MP + 16 * rb + fr, ecol = 32 * cg + 16 * (tid >> 6) + 4 * fq;
        const unsigned long long* ss = (const unsigned long long*)(p->ws + WS_SS) + 7 * (size_t)MPAD;
        const unsigned long long sv = __hip_atomic_load(ss + erow, __ATOMIC_RELAXED, __HIP_MEMORY_SCOPE_AGENT);
        const float rstd = rsqrtf((float)sv * (1.0f / (1024.0f * 1048576.0f)) + EPS);
        float* x = p->out + (size_t)erow * D + ecol;
        *(f32x4*)x = *(const f32x4*)x * rstd * *(const f32x4*)(p->in[7] + ecol); }
}

__global__ void __launch_bounds__(NTHR) fwd_kernel(Params p_) {
    KP p = (KP)__builtin_amdgcn_kernarg_segment_ptr();
    extern __shared__ __attribute__((aligned(16))) unsigned char lds[];
    cg::grid_group grid = cg::this_grid();
    const int bid = blockIdx.x, G = gridDim.x, tid = threadIdx.x;
    const int ph_lo = p->ph_lo, ph_hi = p->ph_hi;
    volatile LAS unsigned* xst = (volatile LAS unsigned*)((LAS unsigned char*)lds + LDS_TOTAL);
    if (threadIdx.x < 4) xst[threadIdx.x] = 0u;
    __syncthreads();
    XcdBarrier xbar; xbar.bar = (unsigned*)(p->ws + WS_BAR); xbar.x = 0; xbar.st = xst;
    if (ph_hi - ph_lo > 1) xbar = xcd_barrier_post((unsigned*)(p->ws + WS_BAR), xst);
    for (int ph = ph_lo; ph < ph_hi; ++ph) {
        if (ph == 2 || ph == 3 || ph == 12 || ph == 14 || ph == 15 || (ph == 24 && G == 256)) continue;
      {
        asm volatile("" : "+s"(p));
        unsigned char* ws = p->ws;
        unsigned long long* SS = (unsigned long long*)(ws + WS_SS);
        bf16_t* XB = (bf16_t*)(ws + WS_XB);
        const int L = (ph - 1) / 12 * 2;
        const int rel = ph == 0 ? 0 : (ph - 1) % 12 + 1;
        const int jj = L >> 1;
        if (ph == 24) {
            for (int u = (G == 256 ? MP / 16 : 0) + bid; u < MR / 16; u += G) final_unit16(p, u);
        } else if (ph == 0) {
            for (int i = bid * NTHR + tid_opaque(); i < 8 * MPAD; i += G * NTHR) SS[i] = 0ull;
            for (int step = 0; step < 2; ++step) {
              if (((step ^ bid) & 1) == 0) { for (int u = bid; u < NG * 4; u += G) ssm_gen_unit(p, 0, u, lds, (bf16_t*)(ws + WS_ACT + A_WG), (bf16_t*)(ws + WS_ACT + A_TV), ws + WS_PAR); }
              else { for (int u = bid; u < MR / 16; u += G) rowss_unit(p, u, lds); } }
        } else if (rel == 1) {
            const bf16_t* WGm = (jj == 0) ? (const bf16_t*)(ws + WS_ACT + A_WG) : (const bf16_t*)(ws + WS_WG1);
            const bf16_t* TVm = (jj == 0) ? (const bf16_t*)(ws + WS_ACT + A_TV) : (const bf16_t*)(ws + WS_TV1);
            const unsigned char* par = ws + WS_PAR + (size_t)jj * PAR_BYTES;
            const float* srcS = (jj == 0) ? p->in[1] : p->out + (size_t)MP * D;
            const unsigned long long* ssrc = SS + (size_t)(jj == 0 ? 8 : 3) * MPAD;
            const float* gain = p->in[5] + (size_t)(2 * jj) * D;
            for (int step = 0; step < 2; ++step) {
              const bool mix = (ph == 1) ? (((step ^ bid) & 1) == 0) : (step == 0);
              if (mix) {
                for (int u = bid; u < NG * 4; u += G) s5_unit(p, jj, ((u >> 3) & 31) + 32 * ((u >> 2) & 1), 2 * (u & 3), WGm, TVm, par, (const bf16_t*)XB, ssrc, gain, lds);
                for (int u = bid; u < 256; u += G) s5_sample_wg(p, jj, u, par, srcS, ssrc + MP, gain);
              } else if (ph == 1) {
                for (int jb = 0; jb < 14; ++jb) {
                    const float* W; bf16_t* Bt; const float* sc = nullptr; int K, N, mode = 0;
                    if (jb < 2) { W = p->in[16] + (size_t)jb * 1024 * 2048; Bt = (bf16_t*)(ws + W_GLU(jb)); K = 1024; N = 2048; mode = 1; }
                    else if (jb < 6) { const int i = jb - 2; W = p->in[20] + (size_t)i * 1024 * 4096; Bt = (bf16_t*)(ws + W_UP(i)); K = 1024; N = 4096; sc = p->in[6] + (size_t)i * D; }
                    else if (jb < 10) { const int i = jb - 6; W = p->in[21] + (size_t)i * 4096 * 1024; Bt = (bf16_t*)(ws + W_DOWN(i)); K = 4096; N = 1024; }
                    else if (jb < 12) { const int i = jb - 10; W = p->in[17] + (size_t)i * 1024 * 3072; Bt = (bf16_t*)(ws + W_IN(i)); K = 1024; N = 3072; mode = 2; sc = p->in[5] + (size_t)(2 * i + 1) * D; }
                    else { const int i = jb - 12; W = p->in[19] + (size_t)i * 1024 * 1024; Bt = (bf16_t*)(ws + W_OUT(i)); K = 1024; N = 1024; }
                    const int ntiles = (K >> 6) * (N >> 6);
                    const int off = (jb == 1) ? 128 : (jb == 11) ? 192 : (jb == 12) ? 128 : (jb == 13) ? 192 : 0;
                    transpose_job(W, Bt, sc, K, N, mode, (bid + G - off % G) % G, G, ntiles / 4, (float*)lds);
                }
              }
            }
        } else if (rel == 8) {
            for (int step = 0; step < 2; ++step) {
              if (((step ^ bid) & 1) == 0) { for (int u = bid; u < 256; u += G) convgate_wg(p, jj, u); }
              else if (ph == 8) { for (int u = bid; u < NG * 4; u += G) ssm_gen_unit(p, 1, u, lds, (bf16_t*)(ws + WS_WG1), (bf16_t*)(ws + WS_TV1), ws + WS_PAR + PAR_BYTES); } }
        } else {
            pg8::StaticOrder S; pg8::Gemm g;
            PG8_LAS unsigned char* l3 = (PG8_LAS unsigned char*)lds;
            if (rel == 4) {
                g = pg8::Gemm{(const bf16_t*)(ws + WS_ACT + A_YACT), (const bf16_t*)(ws + W_GLU(jj)), MP, 2048, 1024};
                S.init(MP, 2048, G, bid);
                { SkArgs a{}; a.A = g.A + (size_t)MP * 1024; a.Bt = g.Bt; a.K = 1024; a.baseS = (L == 0) ? p->in[1] : p->out + (size_t)MP * D; a.X = p->out + (size_t)MP * D; a.XB = XB + (size_t)MP * D; a.ssw = SS + (size_t)(L * 2) * MPAD + MP;
                  for (int sb = bid; sb < 256; sb += G) skinny2d<SK_GLU>(a, sb, lds); }
                pg8::EpiGlu E{L == 0 ? p->in[0] : p->out, L == 0 ? p->in[1] : p->out + (size_t)MP * D, p->out, XB, SS + (size_t)(L * 2) * MPAD};
                pg8::gemm_phase<pg8::EpiGlu, pg8::StaticOrder, GEMM_ALIGN, GEMM_SP2>(l3, g, S, E);
            } else if (rel == 5 || rel == 10) {
                const int layer = L + (rel == 10), ssi = layer * 2;
                g = pg8::Gemm{XB, (const bf16_t*)(ws + W_UP(layer)), MP, 4096, 1024};
                S.init(MP, 4096, G, bid);
                { SkArgs a{}; a.A = g.A + (size_t)MP * 1024; a.Bt = g.Bt; a.K = 1024; a.O = (bf16_t*)(ws + WS_ACT) + (size_t)MP * 4096; a.ssr = SS + (size_t)ssi * MPAD + MP;
                  for (int sb = bid; sb < 256; sb += G) skinny2d<SK_UP>(a, sb, lds); }
                pg8::EpiUp E{(bf16_t*)(ws + WS_ACT), 4096, SS + (size_t)ssi * MPAD};
                pg8::gemm_phase<pg8::EpiUp, pg8::StaticOrder, GEMM_ALIGN, GEMM_SP2>(l3, g, S, E);
            } else if (rel == 6 || rel == 11 || rel == 9) {
                const int layer = L + (rel != 6);
                const int ssi = (rel == 9) ? layer * 2 : layer * 2 + 1;
                if (rel == 9) { g = pg8::Gemm{(const bf16_t*)(ws + WS_ACT + A_Z), (const bf16_t*)(ws + W_OUT(jj)), MP, 1024, 1024}; }
                else { g = pg8::Gemm{(const bf16_t*)(ws + WS_ACT), (const bf16_t*)(ws + W_DOWN(layer)), MP, 1024, 4096}; }
                S.init(MP, 1024, G, bid);
                { SkArgs a{}; a.A = g.A + (size_t)MP * g.K; a.Bt = g.Bt; a.K = g.K; a.baseS = p->out + (size_t)MP * D; a.X = p->out + (size_t)MP * D; a.XB = (ph == 11) ? nullptr : XB + (size_t)MP * D; a.ssw = SS + (size_t)ssi * MPAD + MP;
                  if (g.K == 1024) { for (int sb = bid; sb < 256; sb += G) skinny2d<SK_RES>(a, sb, lds); } else { for (int sb = bid; sb < 256; sb += G) skinny_down2d(a, sb, lds); }
                  if (ph == 23 && G == 256) {
                      asm volatile("s_waitcnt vmcnt(0)" ::: "memory"); __syncthreads();
                      if (threadIdx.x == 0) __hip_atomic_fetch_add((unsigned*)(ws + WS_CNT) + 32, 1u, __ATOMIC_RELAXED, __HIP_MEMORY_SCOPE_AGENT); } }
                if (ph == 23 && G == 256) { pg8::EpiResFinal EF{p->out, p->out, p->in[7], SS + (size_t)ssi * MPAD, (unsigned*)(ws + WS_CNT)};
                    pg8::gemm_phase<pg8::EpiResFinal, pg8::StaticOrder, false, GEMM_SP2>(l3, g, S, EF);
                    decode_final_tail(p, bid, (unsigned*)(ws + WS_CNT) + 32); } else {
                pg8::EpiRes E{p->out, p->out + (size_t)MP * D, p->out, XB, SS + (size_t)ssi * MPAD, ph == 11 ? 1 : 0};
                pg8::gemm_phase<pg8::EpiRes, pg8::StaticOrder, GEMM_ALIGN, GEMM_SP2>(l3, g, S, E); }
            } else {
                g = pg8::Gemm{XB, (const bf16_t*)(ws + W_IN(jj)), MP, 3072, 1024};
                S.init(MP, 3072, G, bid);
                { SkArgs a{}; a.A = g.A + (size_t)MP * 1024; a.Bt = g.Bt; a.K = 1024; a.ssr = SS + (size_t)(L * 2 + 1) * MPAD + MP; a.BG = (bf16_t*)(ws + WS_ACT + A_BG) + (size_t)MP * D; a.CV = (bf16_t*)(ws + WS_ACT + A_CV) + (size_t)MP * D; a.convS = p->out + O_CVS + (size_t)jj * MS * 2 * D;
                  for (int sb = bid; sb < 256; sb += G) skinny2d<SK_WIN>(a, sb, lds); }
                pg8::EpiWin E{(bf16_t*)(ws + WS_ACT + A_BG), (bf16_t*)(ws + WS_ACT + A_CV), SS + (size_t)(L * 2 + 1) * MPAD, p->out + O_CVP + (size_t)jj * 8 * 2 * D, p->out + O_CVS + (size_t)jj * MS * 2 * D};
                pg8::gemm_phase<pg8::EpiWin, pg8::StaticOrder, GEMM_ALIGN, GEMM_SP2>(l3, g, S, E);
            }
        }
      }
        if (ph_hi > 1000) grid.sync();
        if (ph + 1 < ph_hi && !(ph == 23 && G == 256)) xcd_barrier(xbar);
    }
}

extern "C" void kernel_launch(void* const* d_in, const int* in_sizes, int n_in, void* d_out, int out_size, void* d_ws, size_t ws_size, hipStream_t stream) {
    static int grid = 0;
    if (grid == 0) {
        if (n_in != 22 || ws_size < WS_END) { fprintf(stderr, "kernel_launch: need 22 inputs and %zu bytes of workspace; got %d, %zu\n", (size_t)WS_END, n_in, ws_size); grid = -1; return; }
        int dev = 0, cus = 0, per_cu = 0;
        hipGetDevice(&dev); hipDeviceGetAttribute(&cus, hipDeviceAttributeMultiprocessorCount, dev);
        if (hipFuncSetAttribute((const void*)fwd_kernel, hipFuncAttributeMaxDynamicSharedMemorySize, LDS_TOTAL + 16 + 4096) != hipSuccess) { fprintf(stderr, "kernel_launch: hipFuncSetAttribute failed\n"); grid = -1; return; }
        if (hipOccupancyMaxActiveBlocksPerMultiprocessor(&per_cu, (const void*)fwd_kernel, NTHR, LDS_TOTAL + 16 + 4096) != hipSuccess || per_cu < 1) { fprintf(stderr, "kernel_launch: occupancy query says %d\n", per_cu); (void)hipGetLastError(); per_cu = 1; }
        grid = cus;
    }
    if (grid < 0) return;
    Params p{};
    for (int i = 0; i < 22; ++i) p.in[i] = (const float*)d_in[i];
    p.out = (float*)d_out; p.ws = (unsigned char*)d_ws;
#if defined(MULTI_LAUNCH)
    for (int ph = 0; ph < 25; ++ph) { p.ph_lo = ph; p.ph_hi = ph + 1; hipLaunchKernelGGL(fwd_kernel, dim3(grid), dim3(NTHR), LDS_TOTAL + 16 + 4096, stream, p); }
#else
    p.ph_lo = 0; p.ph_hi = 25;
    if (hipMemsetAsync((char*)d_ws + WS_BAR, 0, 32768, stream) != hipSuccess) { fprintf(stderr, "kernel_launch: memset failed\n"); return; }
    void* args[] = {&p};
    hipError_t e = hipLaunchCooperativeKernel((const void*)fwd_kernel, dim3(grid), dim3(NTHR), args, LDS_TOTAL + 16 + 4096, stream);
    if (e != hipSuccess) fprintf(stderr, "cooperative launch failed: %s (grid %d)\n", hipGetErrorString(e), grid);
#endif
}
```
